# Optimizing an MI355X kernel written in HIP

```python
import math
import jax, jax.numpy as jnp
from jax import lax
import numpy as np

D_MODEL = 1024
BATCH = 8
SEQ = 4096
DEPTH = 2

PLE_DIM = 256
N_EVEN = (DEPTH + 1) // 2
N_ODD = DEPTH // 2
S5_WIDTH = D_MODEL // 2
S5_GROUP = 16
S5_GROUPS = S5_WIDTH // S5_GROUP
S5_STATE = 64
SB_HEAD_DIM = 64
SB_HEADS = (D_MODEL // 2) // SB_HEAD_DIM
SB_WIDTH = SB_HEADS * SB_HEAD_DIM
MIX_WIDTH = S5_WIDTH + SB_WIDTH
IN_WIDTH = S5_WIDTH + 3 * SB_WIDTH
Q_BLOCK = 128
POOL_WINDOWS = (2, 4, 8, 16)
POOL_GROUP = D_MODEL // len(POOL_WINDOWS)
D_FF = 4 * D_MODEL
EPS = 1e-6
DT_MIN = 1e-3
DT_MAX = 1e-1

kernel_name = "hybrid_s5_stickbreak_pool_trunk"


def rms_norm(x, gain):
    xf = x.astype(jnp.float32)
    y = xf * lax.rsqrt(jnp.mean(xf * xf, axis=-1, keepdims=True) + EPS)
    return (y * gain.astype(jnp.float32)).astype(x.dtype)


def _cmul(ar, ai, br, bi):
    return ar * br - ai * bi, ar * bi + ai * br


def _s5_combine(earlier, later):
    a1r, a1i, b1r, b1i = earlier
    a2r, a2i, b2r, b2i = later
    ar, ai = _cmul(a2r, a2i, a1r, a1i)
    cr, ci = _cmul(a2r, a2i, b1r, b1i)
    return ar, ai, cr + b2r, ci + b2i


def s5_mixer(u, lam_re, lam_im, log_dt, b_re, b_im, c_re, c_im, d, w_glu):
    bsz, seqlen, _ = u.shape
    f32 = jnp.float32
    uf = u.astype(f32)
    ug = uf.reshape(bsz, seqlen, S5_GROUPS, S5_GROUP)
    lr = lam_re.astype(f32)
    li = lam_im.astype(f32)
    dt = jnp.exp(log_dt.astype(f32))[:, None]
    mag = jnp.exp(lr * dt)
    abar_r = mag * jnp.cos(li * dt)
    abar_i = mag * jnp.sin(li * dt)
    den = lr * lr + li * li
    nr = abar_r - 1.0
    ni = abar_i
    fr = (nr * lr + ni * li) / den
    fi = (ni * lr - nr * li) / den
    br = b_re.astype(f32)
    bi = b_im.astype(f32)
    bbar_r = fr[..., None] * br - fi[..., None] * bi
    bbar_i = fr[..., None] * bi + fi[..., None] * br
    bu_r = jnp.einsum('blgh,gph->blgp', ug, bbar_r)
    bu_i = jnp.einsum('blgh,gph->blgp', ug, bbar_i)
    a_r = jnp.broadcast_to(abar_r, bu_r.shape)
    a_i = jnp.broadcast_to(abar_i, bu_i.shape)
    _, _, x_r, x_i = lax.associative_scan(_s5_combine, (a_r, a_i, bu_r, bu_i), axis=1)
    y = (jnp.einsum('blgp,ghp->blgh', x_r, c_re.astype(f32))
         - jnp.einsum('blgp,ghp->blgh', x_i, c_im.astype(f32)))
    y = y.reshape(bsz, seqlen, S5_WIDTH) + d.astype(f32) * uf
    y = jax.nn.gelu(y)
    y = y * jax.nn.sigmoid(y @ w_glu.astype(f32))
    return y.astype(u.dtype)


def stick_breaking_attention(q, k, v):
    bsz, nh, seqlen, dh = q.shape
    n_blocks = seqlen // Q_BLOCK
    scale = dh ** -0.5
    qf = q.astype(jnp.float32)
    kf = k.astype(jnp.float32)
    q_blocks = qf.reshape(bsz, nh, n_blocks, Q_BLOCK, dh).transpose(2, 0, 1, 3, 4)
    key_pos = jnp.arange(seqlen)

    def one_block(args):
        qb, blk = args
        z = jnp.einsum('bhqd,bhkd->bhqk', qb, kf) * scale
        q_pos = blk * Q_BLOCK + jnp.arange(Q_BLOCK)
        causal = key_pos[None, :] < q_pos[:, None]
        log_beta = jax.nn.log_sigmoid(z)
        log_1m_beta = jnp.where(causal, jax.nn.log_sigmoid(-z), 0.0)
        tail = lax.cumsum(log_1m_beta, axis=3, reverse=True) - log_1m_beta
        w = jnp.where(causal, jnp.exp(log_beta + tail), 0.0)
        return jnp.einsum('bhqk,bhkd->bhqd', w.astype(v.dtype), v)

    out = lax.map(one_block, (q_blocks, jnp.arange(n_blocks)))
    return out.transpose(1, 2, 0, 3, 4).reshape(bsz, nh, seqlen, dh)


def causal_window_mean(x, window):
    seqlen = x.shape[1]
    cs = jnp.cumsum(x, axis=1)
    shifted = jnp.pad(cs, ((0, 0), (window, 0), (0, 0)))[:, :seqlen]
    count = jnp.minimum(jnp.arange(seqlen) + 1, window).astype(jnp.float32)
    return (cs - shifted) / count[None, :, None]


def pool_mixer(h, pool_w, pool_scale):
    bsz, seqlen, _ = h.shape
    hf = h.astype(jnp.float32)
    outs = []
    for g, window in enumerate(POOL_WINDOWS):
        xg = hf[..., g * POOL_GROUP:(g + 1) * POOL_GROUP]
        outs.append(causal_window_mean(xg, window) - xg)
    y = jnp.stack(outs, axis=2)
    y = jnp.einsum('blgc,gcd->blgd', y, pool_w.astype(jnp.float32))
    y = y.reshape(bsz, seqlen, D_MODEL) * pool_scale.astype(jnp.float32)
    return y.astype(h.dtype)


def even_mixer(h, ln, w_in, lam_re, lam_im, log_dt, b_re, b_im, c_re, c_im, d, w_glu,
               q_gain, k_gain, w_out):
    bsz, seqlen, _ = h.shape
    hn = rms_norm(h, ln)
    proj = hn @ w_in
    u = proj[..., :S5_WIDTH]
    q, k, v = jnp.split(proj[..., S5_WIDTH:], 3, axis=-1)
    to_heads = lambda t: t.reshape(bsz, seqlen, SB_HEADS, SB_HEAD_DIM).transpose(0, 2, 1, 3)
    q = rms_norm(to_heads(q), q_gain)
    k = rms_norm(to_heads(k), k_gain)
    v = to_heads(v)
    sb = stick_breaking_attention(q, k, v).transpose(0, 2, 1, 3).reshape(bsz, seqlen, SB_WIDTH)
    s5 = s5_mixer(u, lam_re, lam_im, log_dt, b_re, b_im, c_re, c_im, d, w_glu)
    mixed = jnp.concatenate([s5, sb.astype(s5.dtype)], axis=-1)
    return mixed @ w_out


def setup_inputs(seed: int = 0) -> dict:
    key = jax.random.key(seed)
    ks = jax.random.split(key, 32)
    f32 = jnp.float32
    nrm = lambda k, shape, scale: scale * jax.random.normal(k, shape, f32)
    gain = lambda k, shape: 1.0 + 0.01 * jax.random.normal(k, shape, f32)
    n = jnp.arange(S5_STATE, dtype=f32)
    return {
        'x': nrm(ks[0], (BATCH, SEQ, D_MODEL), 1.0),
        'p': nrm(ks[1], (DEPTH, BATCH, SEQ, PLE_DIM), 1.0),
        'ln_mix_even': gain(ks[2], (N_EVEN, D_MODEL)),
        'w_in_even': nrm(ks[3], (N_EVEN, D_MODEL, IN_WIDTH), D_MODEL ** -0.5),
        's5_lambda_re': -0.5 + nrm(ks[4], (N_EVEN, S5_GROUPS, S5_STATE), 0.01),
        's5_lambda_im': jnp.pi * n + nrm(ks[5], (N_EVEN, S5_GROUPS, S5_STATE), 0.01),
        's5_log_dt': jax.random.uniform(ks[6], (N_EVEN, S5_GROUPS), f32,
                                        math.log(DT_MIN), math.log(DT_MAX)),
        's5_b_re': nrm(ks[7], (N_EVEN, S5_GROUPS, S5_STATE, S5_GROUP), (2.0 * S5_GROUP) ** -0.5),
        's5_b_im': nrm(ks[8], (N_EVEN, S5_GROUPS, S5_STATE, S5_GROUP), (2.0 * S5_GROUP) ** -0.5),
        's5_c_re': nrm(ks[9], (N_EVEN, S5_GROUPS, S5_GROUP, S5_STATE), S5_STATE ** -0.5),
        's5_c_im': nrm(ks[10], (N_EVEN, S5_GROUPS, S5_GROUP, S5_STATE), S5_STATE ** -0.5),
        's5_d': nrm(ks[11], (N_EVEN, S5_WIDTH), 1.0),
        's5_w_glu': nrm(ks[12], (N_EVEN, S5_WIDTH, S5_WIDTH), S5_WIDTH ** -0.5),
        'sb_q_gain': gain(ks[13], (N_EVEN, SB_HEAD_DIM)),
        'sb_k_gain': gain(ks[14], (N_EVEN, SB_HEAD_DIM)),
        'w_out_even': nrm(ks[15], (N_EVEN, MIX_WIDTH, D_MODEL), MIX_WIDTH ** -0.5),
        'ln_mix_odd': gain(ks[16], (N_ODD, D_MODEL)),
        'pool_w': nrm(ks[17], (N_ODD, len(POOL_WINDOWS), POOL_GROUP, POOL_GROUP), POOL_GROUP ** -0.5),
        'pool_scale': gain(ks[18], (N_ODD, D_MODEL)),
        'ln_mlp': gain(ks[19], (DEPTH, D_MODEL)),
        'w_mlp_up': nrm(ks[20], (DEPTH, D_MODEL, D_FF), D_MODEL ** -0.5),
        'w_mlp_down': nrm(ks[21], (DEPTH, D_FF, D_MODEL), 0.5 * D_FF ** -0.5),
        'ln_ple': gain(ks[22], (DEPTH, D_MODEL)),
        'w_ple_gate': nrm(ks[23], (DEPTH, D_MODEL, D_MODEL), D_MODEL ** -0.5),
        'w_ple_up': nrm(ks[24], (DEPTH, PLE_DIM, D_MODEL), PLE_DIM ** -0.5),
    }


def reference(x, p, ln_mix_even, w_in_even, s5_lambda_re, s5_lambda_im, s5_log_dt,
              s5_b_re, s5_b_im, s5_c_re, s5_c_im, s5_d, s5_w_glu, sb_q_gain, sb_k_gain,
              w_out_even, ln_mix_odd, pool_w, pool_scale, ln_mlp, w_mlp_up, w_mlp_down,
              ln_ple, w_ple_gate, w_ple_up):
    h = x
    for i in range(DEPTH):
        j = i // 2
        if i % 2 == 0:
            h = h + even_mixer(h, ln_mix_even[j], w_in_even[j], s5_lambda_re[j], s5_lambda_im[j],
                               s5_log_dt[j], s5_b_re[j], s5_b_im[j], s5_c_re[j], s5_c_im[j],
                               s5_d[j], s5_w_glu[j], sb_q_gain[j], sb_k_gain[j], w_out_even[j])
        else:
            h = h + pool_mixer(rms_norm(h, ln_mix_odd[j]), pool_w[j], pool_scale[j])
        hn = rms_norm(h, ln_mlp[i])
        h = h + jnp.square(jax.nn.relu(hn @ w_mlp_up[i])) @ w_mlp_down[i]
        gate = jax.nn.sigmoid(rms_norm(h, ln_ple[i]) @ w_ple_gate[i])
        h = h + (p[i] @ w_ple_up[i]) * gate
    return h
```

```cpp
#include <hip/hip_runtime.h>
#include <hip/hip_cooperative_groups.h>
#include <cstdio>
namespace cg = cooperative_groups;

#define LAS __attribute__((address_space(3)))
typedef unsigned short bf16_t;
typedef short bf16x8 __attribute__((ext_vector_type(8)));
typedef _Float16 f16x8 __attribute__((ext_vector_type(8)));
typedef float f32x4 __attribute__((ext_vector_type(4)));
typedef unsigned u32x4 __attribute__((ext_vector_type(4)));
typedef unsigned u32x2 __attribute__((ext_vector_type(2)));

constexpr int MTOK = 32768, DM = 1024, SEQ = 4096, NBATCH = 8;
constexpr float EPS = 1e-6f;
constexpr int NPHASE = 15;
#ifndef PHMASK
#define PHMASK 0x7fff
#endif
#define PH_ON(k) ((PHMASK >> (k)) & 1)
constexpr int LDS_BYTES = 131072 + 64;
constexpr float SB_EXIT = -40.0f * 1.44269504089f;

constexpr size_t MiB = 1048576;
constexpr size_t WS_WIN = 0;
constexpr size_t WS_WGLU = WS_WIN + 4 * MiB;
constexpr size_t WS_WOUT = WS_WGLU + MiB / 2;
constexpr size_t WS_WUP = WS_WOUT + 2 * MiB;
constexpr size_t WS_WDOWN = WS_WUP + 16 * MiB;
constexpr size_t WS_WGATE = WS_WDOWN + 16 * MiB;
constexpr size_t WS_WPLE = WS_WGATE + 4 * MiB;
constexpr size_t WS_WPOOL = WS_WPLE + MiB;
constexpr size_t WS_WST = WS_WPOOL + MiB / 2;
constexpr size_t WS_WTZ = WS_WST + 8 * MiB;
constexpr size_t WS_AT = WS_WTZ + 20 * MiB;
constexpr size_t WS_BAR = WS_AT + 65536;
constexpr size_t WS_SS = WS_AT + MiB / 4;
constexpr size_t WS_PB = WS_SS + MiB;
constexpr size_t WS_HB = WS_PB + 32 * MiB;
constexpr size_t WS_EB = WS_HB + 64 * MiB;
constexpr size_t WS_R1 = WS_EB + 64 * MiB;
constexpr size_t WS_XB = WS_R1;
constexpr size_t WS_MIXED = WS_R1;
constexpr size_t WS_UCAT = WS_R1 + 64 * MiB;
constexpr size_t WS_Q = WS_UCAT + 40 * MiB;
constexpr size_t WS_K = WS_Q + 32 * MiB;
constexpr size_t WS_V = WS_K + 32 * MiB;
constexpr size_t WS_YBUF = WS_V + 32 * MiB;
constexpr size_t WS_SLOC = WS_YBUF + 32 * MiB;
constexpr size_t WS_HID = WS_R1;
constexpr size_t WS_YP = WS_R1;
constexpr size_t WS_END = WS_R1 + 256 * MiB;

__device__ __forceinline__ unsigned pk2(float lo, float hi) { unsigned r; asm("v_cvt_pk_bf16_f32 %0, %1, %2" : "=v"(r) : "v"(lo), "v"(hi)); return r; }
__device__ __forceinline__ float bf2f(unsigned short b) { return __uint_as_float(((unsigned)b) << 16); }
__device__ __forceinline__ float bflo(unsigned w) { return __uint_as_float(w << 16); }
__device__ __forceinline__ float bfhi(unsigned w) { return __uint_as_float(w & 0xffff0000u); }
__device__ __forceinline__ u32x2 pk4(f32x4 v) { u32x2 w; w.x = pk2(v[0], v[1]); w.y = pk2(v[2], v[3]); return w; }
__device__ __forceinline__ f32x4 unpk4(u32x2 w) { return (f32x4){bflo(w.x), bfhi(w.x), bflo(w.y), bfhi(w.y)}; }
__device__ __forceinline__ u32x4 pk8(f32x4 a, f32x4 b) { u32x4 w; w.x = pk2(a[0], a[1]); w.y = pk2(a[2], a[3]); w.z = pk2(b[0], b[1]); w.w = pk2(b[2], b[3]); return w; }
__device__ __forceinline__ f32x4 unpk8lo(u32x4 w) { return (f32x4){bflo(w.x), bfhi(w.x), bflo(w.y), bfhi(w.y)}; }
__device__ __forceinline__ f32x4 unpk8hi(u32x4 w) { return (f32x4){bflo(w.z), bfhi(w.z), bflo(w.w), bfhi(w.w)}; }
__device__ __forceinline__ float sigmoidf_(float z) { return 1.0f / (1.0f + __expf(-z)); }

namespace pg8 {
constexpr int BM = 256, BK = 64, HALF = 128, HTB = HALF * BK * 2, STAGE_BYTES = 8 * HTB, NXCD = 8, WGM = 2;
__host__ __device__ __forceinline__ int lds_byte(int r, int c) { const int st = (r >> 4) * 2 + (c >> 5), rr = r & 15, cc = c & 31, ob = rr * 64 + cc * 2; return st * 1024 + (ob ^ (((ob >> 9) & 1) << 5)); }
__host__ __device__ __forceinline__ void stage_rc(int b, int& R, int& C) { const int st = b / 1024, sb = b % 1024, swz = sb ^ (((sb >> 9) & 1) << 5); R = (st >> 1) * 16 + swz / 64; C = (st & 1) * 32 + (swz % 64) / 2; }
__host__ __device__ __forceinline__ int perm32(int rho) { const int n = rho >> 4, i = rho & 15; return 8 * (i >> 2) + 4 * n + (i & 3); }
struct Unit { int pm, pn; };
struct Gemm { const bf16_t* A; const bf16_t* Bt; int lda, K; };

struct StaticOrder {
    __device__ bool next_skip(int, Unit&) const { return false; }
    int nM, nN, nwg, G, c, rev;
    __device__ void init(int M, int N, int G_, int c_, int rev_ = 0) { nM = M / BM; nN = N / BM; nwg = nM * nN; G = G_; c = c_; rev = rev_; }
    __device__ bool next(int i, Unit& u) const {
        const int nr = (nwg + G - 1) / G; if (i >= nr) return false;
        const long L = (long)(rev ? nr - 1 - i : i) * G + c; if (L >= nwg) return next_skip(i, u);
        int wgid = (int)L; { const int q = nwg / NXCD, r = nwg % NXCD, xcd = wgid % NXCD, off = wgid / NXCD; wgid = (xcd < r ? xcd * (q + 1) : r * (q + 1) + (xcd - r) * q) + off; }
        const int nig = WGM * nN, gid = wgid / nig, fm = gid * WGM, gsz = (nM - fm) < WGM ? (nM - fm) : WGM;
        u.pm = fm + ((wgid % nig) % gsz); u.pn = (wgid % nig) / gsz; return true;
    }
};
struct OrderS { int G, c; __device__ bool next(int i, Unit& u) const { const int L = i * G + c; if (L >= 128) return false; u.pm = L; u.pn = L >> 2; return true; } };
struct OrderY { int G, c; __device__ bool next(int i, Unit& u) const { const int L = i * G + c; if (L >= 256) return false; u.pm = L >> 1; u.pn = ((L >> 3) << 1) + (L & 1); return true; } };
struct OrderP { int G, c; __device__ bool next(int i, Unit& u) const { const int L = i * G + c; if (L >= 512) return false; u.pm = L; u.pn = L >> 7; return true; } };

template <class Epi, class Sched, bool SP2 = true, bool ALIGN_EPI = true>
__device__ __forceinline__ void gemm_phase(LAS unsigned char* lds, const Gemm g, const Sched& S, const Epi& E) {
    const int tid = threadIdx.x, wid = __builtin_amdgcn_readfirstlane(tid >> 6), lane = tid & 63, wr = wid >> 2, wc = wid & 3, fr = lane & 15, fq = lane >> 4;
    const int K = g.K, nt = K / BK;
    unsigned voffA[2], voffB[2];
#pragma unroll
    for (int i = 0; i < 2; ++i) { int R, C; stage_rc(tid * 16 + i * 8192, R, C);
        const int Rb = Epi::PERM ? ((R & ~31) + perm32(R & 31)) : R;
        voffA[i] = (unsigned)(R * g.lda + C) * 2u; voffB[i] = (unsigned)(Rb * K + C) * 2u; }
    const size_t kstep = (size_t)(BK * 2);
    const size_t hstepA = (size_t)HALF * g.lda * 2, hstepB = (size_t)HALF * K * 2;
    const size_t tstepA = 2 * hstepA, tstepB = 2 * hstepB;
    const unsigned ldsw = (unsigned)wid * 1024u;
    const int aoff = lds_byte(wr * 64 + fr, fq * 8), boff = lds_byte(wc * 32 + fr, fq * 8);
#define PG8_SA(b, h) (((b) * 2 + (h)) * HTB)
#define PG8_SB(b, h) ((4 + (b) * 2 + (h)) * HTB)
#define PG8_STAGE(bufoff, gbase, voff) do { _Pragma("unroll") for (int _i = 0; _i < 2; ++_i) \
        __builtin_amdgcn_global_load_lds((const unsigned*)((const char*)(gbase) + (voff)[_i]), (LAS unsigned*)(lds + (bufoff) + ldsw + _i * 8192), 16, 0, 0); } while (0)
#define PG8_LDA(dst, b, h) do { _Pragma("unroll") for (int m = 0; m < 4; ++m) _Pragma("unroll") for (int k = 0; k < 2; ++k) dst[m][k] = *(const LAS bf16x8*)(lds + PG8_SA(b, h) + aoff + m * 2048 + k * 1024); } while (0)
#define PG8_LDB(dst, b, h) do { _Pragma("unroll") for (int n = 0; n < 2; ++n) _Pragma("unroll") for (int k = 0; k < 2; ++k) dst[n][k] = *(const LAS bf16x8*)(lds + PG8_SB(b, h) + boff + n * 2048 + k * 1024); } while (0)
#define PG8_MMA(ai, bj, At, Bt) do { __builtin_amdgcn_s_setprio(1); _Pragma("unroll") for (int m = 0; m < 4; ++m) _Pragma("unroll") for (int n = 0; n < 2; ++n) _Pragma("unroll") for (int k = 0; k < 2; ++k) \
        acc[ai][bj][m][n] = __builtin_amdgcn_mfma_f32_16x16x32_bf16(Bt[n][k], At[m][k], acc[ai][bj][m][n], 0, 0, 0); __builtin_amdgcn_s_setprio(0); } while (0)
#define PG8_WAIT_V(n) asm volatile("s_waitcnt vmcnt(" #n ")" ::: "memory")
#define PG8_WAIT_L(n) asm volatile("s_waitcnt lgkmcnt(" #n ")" ::: "memory")
#define PG8_BAR __builtin_amdgcn_s_barrier()
#define PG8_SCHED __builtin_amdgcn_sched_barrier(0)
    Unit cur, nxt; int ui = 0;
    if (!S.next(0, cur)) return;
    typename Epi::Pre pre;
    constexpr bool HASPRE = sizeof(typename Epi::Pre) > 1;
    f32x4 acc[2][2][4][2];
#pragma unroll
    for (int a = 0; a < 2; ++a)
#pragma unroll
        for (int b = 0; b < 2; ++b)
#pragma unroll
            for (int m = 0; m < 4; ++m)
#pragma unroll
                for (int n = 0; n < 2; ++n) acc[a][b][m][n] = (f32x4){0.f, 0.f, 0.f, 0.f};
    bf16x8 At[4][2], B0[2][2], B1[2][2];
    const char* cA = (const char*)g.A + (size_t)cur.pm * tstepA; const char* cB = (const char*)g.Bt + (size_t)cur.pn * tstepB;
    if constexpr (SP2) {
        PG8_STAGE(PG8_SB(0, 0), cB, voffB); PG8_STAGE(PG8_SB(0, 1), cB + hstepB, voffB); PG8_STAGE(PG8_SA(0, 0), cA, voffA); PG8_STAGE(PG8_SA(0, 1), cA + hstepA, voffA);
        if (wr == 1) PG8_BAR;
        PG8_WAIT_V(2); PG8_BAR;
        PG8_STAGE(PG8_SB(1, 0), cB + kstep, voffB); PG8_STAGE(PG8_SA(1, 0), cA + kstep, voffA); PG8_STAGE(PG8_SB(1, 1), cB + hstepB + kstep, voffB);
        PG8_WAIT_V(6); PG8_BAR;
    } else {
        PG8_STAGE(PG8_SB(0, 0), cB, voffB); PG8_STAGE(PG8_SA(0, 0), cA, voffA); PG8_STAGE(PG8_SB(0, 1), cB + hstepB, voffB); PG8_STAGE(PG8_SA(0, 1), cA + hstepA, voffA);
        if (wr == 1) PG8_BAR;
        PG8_WAIT_V(4); PG8_BAR;
        PG8_STAGE(PG8_SB(1, 0), cB + kstep, voffB); PG8_STAGE(PG8_SA(1, 0), cA + kstep, voffA); PG8_STAGE(PG8_SB(1, 1), cB + hstepB + kstep, voffB);
        PG8_WAIT_V(6); PG8_BAR;
    }
    for (;;) {
        const bool has_next = S.next(ui + 1, nxt);
        const char* nA = has_next ? (const char*)g.A + (size_t)nxt.pm * tstepA : cA; const char* nB = has_next ? (const char*)g.Bt + (size_t)nxt.pn * tstepB : cB;
        for (int t = 0; t < nt; t += 2) {
            const bool last = (t == nt - 2);
            const char* a1 = cA + (size_t)(t + 1) * kstep;
            const char* a2 = last ? nA : cA + (size_t)(t + 2) * kstep; const char* b2 = last ? nB : cB + (size_t)(t + 2) * kstep;
            const char* a3 = a2 + kstep; const char* b3 = b2 + kstep;
            if (last) E.pre(pre, cur, wr, fr);
            if constexpr (SP2) {
            PG8_LDB(B0, 0, 0); PG8_LDB(B1, 0, 1); PG8_SCHED; PG8_LDA(At, 0, 0); PG8_STAGE(PG8_SA(1, 1), a1 + hstepA, voffA);
            if (HASPRE && last) { PG8_WAIT_V(16); } else { PG8_WAIT_V(8); }
            PG8_WAIT_L(0); PG8_BAR; PG8_MMA(0, 0, At, B0); PG8_MMA(0, 1, At, B1); PG8_BAR; PG8_SCHED;
            PG8_LDA(At, 0, 1); PG8_STAGE(PG8_SB(0, 0), b2, voffB); PG8_STAGE(PG8_SB(0, 1), b2 + hstepB, voffB); PG8_STAGE(PG8_SA(0, 0), a2, voffA);
            if (HASPRE && last) { PG8_WAIT_V(16); } else { PG8_WAIT_V(8); }
            PG8_WAIT_L(0); PG8_BAR; PG8_MMA(1, 0, At, B0); PG8_MMA(1, 1, At, B1); PG8_BAR; PG8_SCHED;
            PG8_LDB(B0, 1, 0); PG8_LDB(B1, 1, 1); PG8_SCHED; PG8_LDA(At, 1, 0); PG8_STAGE(PG8_SA(0, 1), a2 + hstepA, voffA);
            PG8_WAIT_V(8); PG8_WAIT_L(0); PG8_BAR; PG8_MMA(0, 0, At, B0); PG8_MMA(0, 1, At, B1); PG8_BAR; PG8_SCHED;
            PG8_LDA(At, 1, 1); PG8_STAGE(PG8_SB(1, 0), b3, voffB); PG8_STAGE(PG8_SB(1, 1), b3 + hstepB, voffB); PG8_STAGE(PG8_SA(1, 0), a3, voffA);
            PG8_WAIT_V(8); PG8_WAIT_L(0); PG8_BAR; PG8_MMA(1, 0, At, B0); PG8_MMA(1, 1, At, B1); PG8_BAR; PG8_SCHED;
            } else {
            PG8_LDB(B0, 0, 0); PG8_SCHED; PG8_LDA(At, 0, 0); PG8_STAGE(PG8_SA(1, 1), a1 + hstepA, voffA);
            PG8_WAIT_L(8); PG8_BAR; PG8_WAIT_L(0); PG8_MMA(0, 0, At, B0); PG8_BAR; PG8_SCHED;
            PG8_LDB(B1, 0, 1); PG8_STAGE(PG8_SB(0, 0), b2, voffB);
            PG8_BAR; PG8_WAIT_L(0); PG8_MMA(0, 1, At, B1); PG8_BAR;
            PG8_LDA(At, 0, 1); PG8_STAGE(PG8_SA(0, 0), a2, voffA);
            PG8_BAR; PG8_WAIT_L(0); PG8_MMA(1, 0, At, B0); PG8_BAR; PG8_SCHED;
            PG8_STAGE(PG8_SB(0, 1), b2 + hstepB, voffB);
            PG8_WAIT_V(6); PG8_BAR; PG8_MMA(1, 1, At, B1); PG8_BAR;
            PG8_LDB(B0, 1, 0); PG8_SCHED; PG8_LDA(At, 1, 0); PG8_STAGE(PG8_SA(0, 1), a2 + hstepA, voffA);
            PG8_WAIT_L(8); PG8_BAR; PG8_WAIT_L(0); PG8_MMA(0, 0, At, B0); PG8_BAR; PG8_SCHED;
            PG8_LDB(B1, 1, 1); PG8_STAGE(PG8_SB(1, 0), b3, voffB);
            PG8_BAR; PG8_WAIT_L(0); PG8_MMA(0, 1, At, B1); PG8_BAR;
            PG8_LDA(At, 1, 1); PG8_STAGE(PG8_SA(1, 0), a3, voffA);
            PG8_BAR; PG8_WAIT_L(0); PG8_MMA(1, 0, At, B0); PG8_BAR; PG8_SCHED;
            PG8_STAGE(PG8_SB(1, 1), b3 + hstepB, voffB);
            PG8_WAIT_V(6); PG8_BAR; PG8_MMA(1, 1, At, B1); PG8_BAR;
            }
        }
        if constexpr (ALIGN_EPI) { if (wr == 0) PG8_BAR; }
        E(acc, cur, wr, wc, fr, fq, pre);
        if (!has_next) break;
#pragma unroll
        for (int a = 0; a < 2; ++a)
#pragma unroll
            for (int b = 0; b < 2; ++b)
#pragma unroll
                for (int m = 0; m < 4; ++m)
#pragma unroll
                    for (int n = 0; n < 2; ++n) acc[a][b][m][n] = (f32x4){0.f, 0.f, 0.f, 0.f};
        cur = nxt; cA = nA; cB = nB; ++ui;
        if constexpr (ALIGN_EPI) { if (wr == 1) PG8_BAR; }
    }
    PG8_WAIT_V(0);
    if constexpr (!ALIGN_EPI) { if (wr == 0) PG8_BAR; }
    PG8_BAR;
#undef PG8_SA
#undef PG8_SB
#undef PG8_STAGE
#undef PG8_LDA
#undef PG8_LDB
#undef PG8_MMA
#undef PG8_WAIT_V
#undef PG8_WAIT_L
#undef PG8_BAR
#undef PG8_SCHED
}
}
using pg8::Unit;
typedef const f32x4 (&AccRef)[2][2][4][2];


struct EpiIn {
    static constexpr bool PERM = true;
    struct Pre { float rs[8]; };
    __device__ __forceinline__ void pre(Pre& p, const Unit& u, int wr, int fr) const {
#pragma unroll
        for (int i = 0; i < 8; ++i) p.rs[i] = ss0[u.pm * 256 + wr * 64 + fr + (i >> 2) * 128 + (i & 3) * 16];
    }
    const float* ss0; bf16_t* ucat; bf16_t* q; bf16_t* k; bf16_t* v; const float* qg; const float* kg;
    __device__ __forceinline__ void operator()(AccRef acc, const Unit& u, int wr, int wc, int fr, int fq, const Pre& pre) const {
        const int row0 = u.pm * 256 + wr * 64 + fr;
        if (u.pn < 2) {
#pragma unroll
            for (int ai = 0; ai < 2; ++ai)
#pragma unroll
                for (int m = 0; m < 4; ++m) {
                    const int row = row0 + ai * 128 + m * 16; const float rs = rsqrtf(pre.rs[ai * 4 + m] * (1.0f / 1024.0f) + EPS);
                    const int b = row >> 12, l = row & 4095, sc = l >> 5, s = l & 31;
#pragma unroll
                    for (int bj = 0; bj < 2; ++bj) {
                        const int c = u.pn * 256 + bj * 128 + wc * 32 + 8 * fq, g = c >> 4, hi = c & 15;
                        bf16_t* dst = ucat + (size_t)(g * 1024 + b * 128 + sc) * 640 + s * 16 + hi;
                        *(u32x4*)dst = pk8(acc[ai][bj][m][0] * rs, acc[ai][bj][m][1] * rs);
                    }
                }
        } else {
            const int t = (u.pn - 2) >> 1, head = ((u.pn - 2) & 1) * 4 + wc;
            bf16_t* base = q + (size_t)t * (size_t)(NBATCH * 8 * SEQ * 64);
            const float* gp = t == 0 ? qg : kg;
#pragma unroll
            for (int ai = 0; ai < 2; ++ai)
#pragma unroll
                for (int m = 0; m < 4; ++m) {
                    const int row = row0 + ai * 128 + m * 16; const float rs = rsqrtf(pre.rs[ai * 4 + m] * (1.0f / 1024.0f) + EPS);
                    const int b = row >> 12, l = row & 4095;
                    float sc2 = rs;
                    if (t < 2) {
                        float ssq = 0.f;
#pragma unroll
                        for (int bj = 0; bj < 2; ++bj)
#pragma unroll
                            for (int n = 0; n < 2; ++n) { const f32x4 x = acc[ai][bj][m][n]; ssq += (x[0] * x[0] + x[1] * x[1]) + (x[2] * x[2] + x[3] * x[3]); }
                        ssq += __shfl_xor(ssq, 16); ssq += __shfl_xor(ssq, 32);
                        sc2 = rs * rsqrtf(ssq * rs * rs * (1.0f / 64.0f) + EPS) * (t == 0 ? 0.125f * 1.44269504089f : 1.0f);
                    }
                    bf16_t* dst = base + ((size_t)(b * 8 + head) * 4096 + l) * 64;
#pragma unroll
                    for (int bj = 0; bj < 2; ++bj) {
                        f32x4 v0 = acc[ai][bj][m][0] * sc2, v1 = acc[ai][bj][m][1] * sc2;
                        if (t < 2) { v0 = v0 * *(const f32x4*)(gp + 32 * bj + 8 * fq); v1 = v1 * *(const f32x4*)(gp + 32 * bj + 8 * fq + 4); }
                        *(u32x4*)(dst + 32 * bj + 8 * fq) = pk8(v0, v1);
                    }
                    asm volatile("" ::: "memory");
                }
        }
    }
};
struct EpiS {
    static constexpr bool PERM = true;
    struct Pre {}; __device__ __forceinline__ void pre(Pre&, const Unit&, int, int) const {}
    float* sloc;
    __device__ __forceinline__ void operator()(AccRef acc, const Unit& u, int wr, int wc, int fr, int fq, const Pre& pre) const {
        const int row0 = u.pm * 256 + wr * 64 + fr;
#pragma unroll
        for (int ai = 0; ai < 2; ++ai)
#pragma unroll
            for (int m = 0; m < 4; ++m) { float* rp = sloc + (size_t)(row0 + ai * 128 + m * 16) * 128 + wc * 32 + 8 * fq;
                *(f32x4*)rp = acc[ai][0][m][0]; *(f32x4*)(rp + 4) = acc[ai][0][m][1]; }
    }
};
struct EpiY {
    static constexpr bool PERM = true;
    struct Pre {}; __device__ __forceinline__ void pre(Pre&, const Unit&, int, int) const {}
    const bf16_t* ucat; const float* dvec; bf16_t* ybuf;
    __device__ __forceinline__ void operator()(AccRef acc, const Unit& u, int wr, int wc, int fr, int fq, const Pre& pre) const {
        const int g = u.pm >> 2;
#pragma unroll
        for (int ai = 0; ai < 2; ++ai)
#pragma unroll
            for (int m = 0; m < 4; ++m) {
                const int R = u.pm * 256 + ai * 128 + wr * 64 + m * 16 + fr, rem = R & 1023, b = rem >> 7, sc = rem & 127;
#pragma unroll
                for (int bj = 0; bj < 2; ++bj) {
                    const int nc = (u.pn & 1) * 256 + bj * 128 + wc * 32 + 8 * fq, t = nc >> 4, ho = nc & 15, ch = g * 16 + ho, l = sc * 32 + t;
                    const u32x4 uw = *(const u32x4*)(ucat + (size_t)R * 640 + nc);
                    f32x4 y0 = acc[ai][bj][m][0] + *(const f32x4*)(dvec + ch) * unpk8lo(uw), y1 = acc[ai][bj][m][1] + *(const f32x4*)(dvec + ch + 4) * unpk8hi(uw);
#pragma unroll
                    for (int j = 0; j < 4; ++j) { const float v = y0[j]; const float a = 1.5957691216f * (v + 0.044715f * v * v * v); y0[j] = v / (1.0f + __expf(-a));
                                                  const float w = y1[j]; const float c = 1.5957691216f * (w + 0.044715f * w * w * w); y1[j] = w / (1.0f + __expf(-c)); }
                    *(u32x4*)(ybuf + (size_t)(b * 4096 + l) * 512 + ch) = pk8(y0, y1);
                }
            }
    }
};
struct EpiGlu {
    static constexpr bool PERM = true;
    struct Pre {}; __device__ __forceinline__ void pre(Pre&, const Unit&, int, int) const {}
    const bf16_t* ybuf; bf16_t* mixed;
    __device__ __forceinline__ void operator()(AccRef acc, const Unit& u, int wr, int wc, int fr, int fq, const Pre& pre) const {
        const int row0 = u.pm * 256 + wr * 64 + fr, col0 = u.pn * 256 + wc * 32 + 8 * fq;
#pragma unroll
        for (int ai = 0; ai < 2; ++ai)
#pragma unroll
            for (int m = 0; m < 4; ++m) { const int row = row0 + ai * 128 + m * 16;
#pragma unroll
                for (int bj = 0; bj < 2; ++bj) { const int c = col0 + bj * 128;
                    const u32x4 yw = *(const u32x4*)(ybuf + (size_t)row * 512 + c); const f32x4 ya = unpk8lo(yw), yb = unpk8hi(yw); f32x4 o0, o1;
#pragma unroll
                    for (int j = 0; j < 4; ++j) { o0[j] = ya[j] * sigmoidf_(acc[ai][bj][m][0][j]); o1[j] = yb[j] * sigmoidf_(acc[ai][bj][m][1][j]); }
                    *(u32x4*)(mixed + (size_t)row * 1024 + c) = pk8(o0, o1); } }
    }
};
template <int MODE> struct EpiRes {
    static constexpr bool PERM = true;
    struct Pre {}; __device__ __forceinline__ void pre(Pre&, const Unit&, int, int) const {}
    const void* base; bf16_t* hb; float* ss; const float* cscale;
    __device__ __forceinline__ void operator()(AccRef acc, const Unit& u, int wr, int wc, int fr, int fq, const Pre& pre) const {
        const int pmr = MODE == 2 ? (u.pm & 127) : u.pm;
        const int row0 = pmr * 256 + wr * 64 + fr, col0 = u.pn * 256 + wc * 32 + 8 * fq;
#pragma unroll
        for (int ai = 0; ai < 2; ++ai) {
            u32x4 bw[4][2];
            if (MODE != 0) {
#pragma unroll
                for (int m = 0; m < 4; ++m)
#pragma unroll
                    for (int bj = 0; bj < 2; ++bj) bw[m][bj] = *(const u32x4*)((const bf16_t*)base + (size_t)(row0 + ai * 128 + m * 16) * 1024 + col0 + bj * 128);
            }
#pragma unroll
            for (int m = 0; m < 4; ++m) { const int row = row0 + ai * 128 + m * 16; float part = 0.f;
#pragma unroll
                for (int bj = 0; bj < 2; ++bj) { const size_t o = (size_t)row * 1024 + col0 + bj * 128;
                    f32x4 b0, b1;
                    if (MODE == 0) { b0 = *(const f32x4*)((const float*)base + o); b1 = *(const f32x4*)((const float*)base + o + 4); }
                    else { b0 = unpk8lo(bw[m][bj]); b1 = unpk8hi(bw[m][bj]); }
                    const f32x4 h0 = b0 + acc[ai][bj][m][0], h1 = b1 + acc[ai][bj][m][1];
                    *(u32x4*)(hb + o) = pk8(h0, h1);
                    part += ((h0[0] * h0[0] + h0[1] * h0[1]) + (h0[2] * h0[2] + h0[3] * h0[3])) + ((h1[0] * h1[0] + h1[1] * h1[1]) + (h1[2] * h1[2] + h1[3] * h1[3])); }
                part += __shfl_xor(part, 16); part += __shfl_xor(part, 32);
                if (fq == 0) atomicAdd(ss + row, part); }
            asm volatile("" ::: "memory"); }
    }
};
struct EpiUp {
    static constexpr bool PERM = true;
    struct Pre { float rs[8]; };
    __device__ __forceinline__ void pre(Pre& p, const Unit& u, int wr, int fr) const {
#pragma unroll
        for (int i = 0; i < 8; ++i) p.rs[i] = ss[u.pm * 256 + wr * 64 + fr + (i >> 2) * 128 + (i & 3) * 16];
    }
    const float* ss; bf16_t* hid;
    __device__ __forceinline__ void operator()(AccRef acc, const Unit& u, int wr, int wc, int fr, int fq, const Pre& pre) const {
        const int row0 = u.pm * 256 + wr * 64 + fr, col0 = u.pn * 256 + wc * 32 + 8 * fq;
#pragma unroll
        for (int ai = 0; ai < 2; ++ai)
#pragma unroll
            for (int m = 0; m < 4; ++m) { const int row = row0 + ai * 128 + m * 16; const float rs = rsqrtf(pre.rs[ai * 4 + m] * (1.0f / 1024.0f) + EPS);
#pragma unroll
                for (int bj = 0; bj < 2; ++bj) { f32x4 v0 = acc[ai][bj][m][0] * rs, v1 = acc[ai][bj][m][1] * rs;
#pragma unroll
                    for (int j = 0; j < 4; ++j) { const float r0 = fmaxf(v0[j], 0.f), r1 = fmaxf(v1[j], 0.f); v0[j] = r0 * r0; v1[j] = r1 * r1; }
                    u32x4 w; w.x = pk2(v0[0], v0[1]); w.y = pk2(v0[2], v0[3]); w.z = pk2(v1[0], v1[1]); w.w = pk2(v1[2], v1[3]);
                    __builtin_nontemporal_store(w, (u32x4*)(hid + (size_t)row * 4096 + col0 + bj * 128)); } }
    }
};
struct EpiE {
    static constexpr bool PERM = true;
    struct Pre {}; __device__ __forceinline__ void pre(Pre&, const Unit&, int, int) const {}
    bf16_t* eb;
    __device__ __forceinline__ void operator()(AccRef acc, const Unit& u, int wr, int wc, int fr, int fq, const Pre& pre) const {
        const int row0 = u.pm * 256 + wr * 64 + fr, col0 = u.pn * 256 + wc * 32 + 8 * fq;
#pragma unroll
        for (int ai = 0; ai < 2; ++ai)
#pragma unroll
            for (int m = 0; m < 4; ++m) { const int row = row0 + ai * 128 + m * 16;
#pragma unroll
                for (int bj = 0; bj < 2; ++bj) *(u32x4*)(eb + (size_t)row * 1024 + col0 + bj * 128) = pk8(acc[ai][bj][m][0], acc[ai][bj][m][1]); }
    }
};
template <bool FINAL> struct EpiGate {
    static constexpr bool PERM = true;
    struct Pre { float rs[8]; };
    __device__ __forceinline__ void pre(Pre& p, const Unit& u, int wr, int fr) const {
#pragma unroll
        for (int i = 0; i < 8; ++i) p.rs[i] = ss_in[u.pm * 256 + wr * 64 + fr + (i >> 2) * 128 + (i & 3) * 16];
    }
    const bf16_t* base; float* out; bf16_t* hb2; const bf16_t* eb; const float* ss_in; float* ss_out;
    __device__ __forceinline__ void operator()(AccRef acc, const Unit& u, int wr, int wc, int fr, int fq, const Pre& pre) const {
        const int row0 = u.pm * 256 + wr * 64 + fr, col0 = u.pn * 256 + wc * 32 + 8 * fq;
#pragma unroll
        for (int ai = 0; ai < 2; ++ai) {
            u32x4 bw[4][2], ew[4][2];
#pragma unroll
            for (int m = 0; m < 4; ++m)
#pragma unroll
                for (int bj = 0; bj < 2; ++bj) { const size_t o = (size_t)(row0 + ai * 128 + m * 16) * 1024 + col0 + bj * 128; bw[m][bj] = *(const u32x4*)(base + o); ew[m][bj] = *(const u32x4*)(eb + o); }
#pragma unroll
            for (int m = 0; m < 4; ++m) { const int row = row0 + ai * 128 + m * 16; const float rs = rsqrtf(pre.rs[ai * 4 + m] * (1.0f / 1024.0f) + EPS); float part = 0.f;
#pragma unroll
                for (int bj = 0; bj < 2; ++bj) { const size_t o = (size_t)row * 1024 + col0 + bj * 128;
                    const f32x4 e0 = unpk8lo(ew[m][bj]), e1 = unpk8hi(ew[m][bj]); f32x4 h0 = unpk8lo(bw[m][bj]), h1 = unpk8hi(bw[m][bj]);
#pragma unroll
                    for (int j = 0; j < 4; ++j) { h0[j] += e0[j] * sigmoidf_(acc[ai][bj][m][0][j] * rs); h1[j] += e1[j] * sigmoidf_(acc[ai][bj][m][1][j] * rs); }
                    if (FINAL) { *(f32x4*)(out + o) = h0; *(f32x4*)(out + o + 4) = h1; } else *(u32x4*)(hb2 + o) = pk8(h0, h1);
                    part += ((h0[0] * h0[0] + h0[1] * h0[1]) + (h0[2] * h0[2] + h0[3] * h0[3])) + ((h1[0] * h1[0] + h1[1] * h1[1]) + (h1[2] * h1[2] + h1[3] * h1[3])); }
                if (!FINAL) { part += __shfl_xor(part, 16); part += __shfl_xor(part, 32); if (fq == 0) atomicAdd(ss_out + row, part); } }
            asm volatile("" ::: "memory"); }
    }
};

struct Args {
    const float* in[25]; float* out; unsigned char* ws; int ph_lo, ph_hi;
};
enum { I_X = 0, I_P, I_LN_EVEN, I_WIN, I_LRE, I_LIM, I_LOGDT, I_BRE, I_BIM, I_CRE, I_CIM, I_D, I_WGLU, I_QG, I_KG, I_WOUT, I_LN_ODD, I_POOLW, I_POOLS, I_LN_MLP, I_WUP, I_WDOWN, I_LN_PLE, I_WGATE, I_WPLE };

__device__ __forceinline__ int rowmap_in(int n) {
    if (n < 512) return n;
    const int tile = n >> 8, lc = n & 255, hd = lc >> 6, dd = lc & 63;
    return (tile << 8) + ((dd >> 5) << 7) + (hd << 5) + (dd & 31);
}
__device__ __forceinline__ void xpose_item(const float* W, int K, int N, bf16_t* WT, const float* gain, int mode, LAS float* scr, int item, int lane, const float* ngain = nullptr) {
    const int nblk = N / 32, kb = item / nblk, nb = item % nblk, k0 = 64 * kb, n0 = 32 * nb;
    float wv[32];
#pragma unroll
    for (int i = 0; i < 32; ++i) { const int kk = 2 * i + (lane >> 5); wv[i] = W[(size_t)(k0 + kk) * N + n0 + (lane & 31)]; }
#pragma unroll
    for (int i = 0; i < 32; ++i) { const int kk = 2 * i + (lane >> 5); const float gvv = gain ? gain[k0 + kk] : 1.0f; scr[kk * 33 + (lane & 31)] = wv[i] * gvv; }
    asm volatile("s_waitcnt lgkmcnt(0)" ::: "memory");
    const int c = lane & 7;
#pragma unroll
    for (int j = 0; j < 4; ++j) { const int n = (lane >> 3) + 8 * j; const LAS float* s = scr + (8 * c) * 33 + n;
        const float ng = ngain ? ngain[n0 + n] : 1.0f;
        u32x4 o; o.x = pk2(s[0 * 33] * ng, s[1 * 33] * ng); o.y = pk2(s[2 * 33] * ng, s[3 * 33] * ng); o.z = pk2(s[4 * 33] * ng, s[5 * 33] * ng); o.w = pk2(s[6 * 33] * ng, s[7 * 33] * ng);
        int nr = n0 + n; if (mode == 1) nr = rowmap_in(nr);
        *(u32x4*)(WT + (size_t)nr * K + k0 + 8 * c) = o; }
    asm volatile("s_waitcnt lgkmcnt(0)" ::: "memory");
}
struct C2 { float r, i; };
__device__ __forceinline__ C2 cmul(C2 a, C2 b) { return C2{a.r * b.r - a.i * b.i, a.r * b.i + a.i * b.r}; }
__device__ __forceinline__ C2 s5_apow(float lr, float li, float dt, float tau) {
    const float mag = __expf(lr * dt * tau);
    float sn, cs; sincosf(li * dt * tau, &sn, &cs);
    return C2{mag * cs, mag * sn};
}
__device__ __forceinline__ C2 s5_zoh(float lr, float li, float dt) {
    const float x = lr * dt, y = li * dt;
    float sn, cs; sincosf(y, &sn, &cs);
    const float sh = sinf(0.5f * y), em1 = expm1f(x);
    const float nr = em1 * cs - 2.0f * sh * sh, ni = (em1 + 1.0f) * sn;
    const float den = lr * lr + li * li;
    return C2{(nr * lr + ni * li) / den, (ni * lr - nr * li) / den};
}

__device__ __forceinline__ void phase_prep(const Args& a, LAS unsigned char* lds, int wg, int G) {
    const int tid = threadIdx.x, lane = tid & 63, wid = tid >> 6;
    unsigned char* ws = a.ws;
    const int gw = wg * 8 + wid, NGW = G * 8;
    const size_t gt = (size_t)wg * 512 + tid, NGT = (size_t)G * 512;
    {
        LAS float* scr = (LAS float*)(lds + wid * 8448);
        constexpr int I0 = 1024, I1 = 128, I2 = 512, I3 = 2048, I4 = 2048, I5 = 512, I6 = 128, I7 = 32;
        constexpr int NIT = I0 + I1 + I2 + 2 * I3 + 2 * I4 + 2 * I5 + 2 * I6 + 4 * I7;
        for (int it = gw; it < NIT; it += NGW) {
            int r = it;
            if (r < I0) { xpose_item(a.in[I_WIN], 1024, 2048, (bf16_t*)(ws + WS_WIN), a.in[I_LN_EVEN], 1, scr, r, lane); continue; } r -= I0;
            if (r < I1) { xpose_item(a.in[I_WGLU], 512, 512, (bf16_t*)(ws + WS_WGLU), nullptr, 0, scr, r, lane); continue; } r -= I1;
            if (r < I2) { xpose_item(a.in[I_WOUT], 1024, 1024, (bf16_t*)(ws + WS_WOUT), nullptr, 0, scr, r, lane); continue; } r -= I2;
            if (r < 2 * I3) { const int i = r / I3; xpose_item(a.in[I_WUP] + (size_t)i * 1024 * 4096, 1024, 4096, (bf16_t*)(ws + WS_WUP) + (size_t)i * 4096 * 1024, a.in[I_LN_MLP] + i * 1024, 0, scr, r % I3, lane); continue; } r -= 2 * I3;
            if (r < 2 * I4) { const int i = r / I4; xpose_item(a.in[I_WDOWN] + (size_t)i * 4096 * 1024, 4096, 1024, (bf16_t*)(ws + WS_WDOWN) + (size_t)i * 1024 * 4096, nullptr, 0, scr, r % I4, lane); continue; } r -= 2 * I4;
            if (r < 2 * I5) { const int i = r / I5; xpose_item(a.in[I_WGATE] + (size_t)i * 1024 * 1024, 1024, 1024, (bf16_t*)(ws + WS_WGATE) + (size_t)i * 1024 * 1024, a.in[I_LN_PLE] + i * 1024, 0, scr, r % I5, lane); continue; } r -= 2 * I5;
            if (r < 2 * I6) { const int i = r / I6; xpose_item(a.in[I_WPLE] + (size_t)i * 256 * 1024, 256, 1024, (bf16_t*)(ws + WS_WPLE) + (size_t)i * 1024 * 256, nullptr, 0, scr, r % I6, lane); continue; } r -= 2 * I6;
            { const int i = r / I7; xpose_item(a.in[I_POOLW] + (size_t)i * 256 * 256, 256, 256, (bf16_t*)(ws + WS_WPOOL) + (size_t)i * 256 * 256, a.in[I_LN_ODD] + i * 256, 0, scr, r % I7, lane, a.in[I_POOLS] + i * 256); }
        }
    }
    {
        const float* x = a.in[I_X]; bf16_t* xb = (bf16_t*)a.out + (size_t)MTOK * 1024; float* ss0 = (float*)(ws + WS_SS);
        for (int m = 2 * gw; m < MTOK; m += 2 * NGW) {
            const f32x4* xr = (const f32x4*)(x + (size_t)m * 1024) + lane; u32x2* o = (u32x2*)(xb + (size_t)m * 1024) + lane;
            f32x4 v[8];
#pragma unroll
            for (int j = 0; j < 8; ++j) v[j] = xr[64 * j];
            float s0 = 0.f, s1 = 0.f;
#pragma unroll
            for (int j = 0; j < 4; ++j) { s0 += (v[j][0] * v[j][0] + v[j][1] * v[j][1]) + (v[j][2] * v[j][2] + v[j][3] * v[j][3]); s1 += (v[4 + j][0] * v[4 + j][0] + v[4 + j][1] * v[4 + j][1]) + (v[4 + j][2] * v[4 + j][2] + v[4 + j][3] * v[4 + j][3]); }
#pragma unroll
            for (int j = 0; j < 8; ++j) o[64 * j] = pk4(v[j]);
#pragma unroll
            for (int off = 1; off < 64; off <<= 1) { s0 += __shfl_xor(s0, off); s1 += __shfl_xor(s1, off); }
            if (lane == 0) { ss0[m] = s0; ss0[m + 1] = s1; }
        }
    }
    {
        const f32x4* p4 = (const f32x4*)a.in[I_P]; u32x2* pb = (u32x2*)(ws + WS_PB);
        for (size_t i = gt; i < (size_t)2 * MTOK * 256 / 4; i += 4 * NGT) {
            f32x4 v[4];
#pragma unroll
            for (int j = 0; j < 4; ++j) v[j] = (i + j * NGT < (size_t)2 * MTOK * 256 / 4) ? p4[i + j * NGT] : (f32x4){0.f, 0.f, 0.f, 0.f};
#pragma unroll
            for (int j = 0; j < 4; ++j) if (i + j * NGT < (size_t)2 * MTOK * 256 / 4) pb[i + j * NGT] = pk4(v[j]);
        }
        float* ss = (float*)(ws + WS_SS) + MTOK;
        for (size_t i = gt; i < (size_t)5 * MTOK; i += NGT) ss[i] = 0.f;
    }
    const float* lre = a.in[I_LRE]; const float* lim = a.in[I_LIM]; const float* ldt = a.in[I_LOGDT];
    const float* bre = a.in[I_BRE]; const float* bim = a.in[I_BIM]; const float* cre = a.in[I_CRE]; const float* cim = a.in[I_CIM];
    bf16_t* wst = (bf16_t*)(ws + WS_WST); bf16_t* wtz = (bf16_t*)(ws + WS_WTZ); float* at = (float*)(ws + WS_AT);
    for (size_t i = gt; i < 2048; i += NGT) { const int g = (int)i >> 6; const float dt = __expf(ldt[g]); const C2 ap = s5_apow(lre[i], lim[i], dt, 32.0f); at[2 * i] = ap.r; at[2 * i + 1] = ap.i; }
    for (size_t i = gt; i < (size_t)32 * 64 * 32; i += NGT) {
        const int s = (int)i & 31, gp = (int)(i >> 5), g = gp >> 6, p = gp & 63;
        const float dt = __expf(ldt[g]), lr = lre[gp], li = lim[gp];
        const C2 co = cmul(s5_apow(lr, li, dt, (float)(31 - s)), s5_zoh(lr, li, dt));
        const float* br = bre + (size_t)gp * 16; const float* bi = bim + (size_t)gp * 16;
        float vr[16], vi[16];
#pragma unroll
        for (int h = 0; h < 16; ++h) { const C2 v = cmul(co, C2{br[h], bi[h]}); vr[h] = v.r; vi[h] = v.i; }
        bf16_t* d0 = wst + (size_t)(g * 256 + 2 * p) * 512 + s * 16; bf16_t* d1 = d0 + 512;
        u32x4 w;
        w.x = pk2(vr[0], vr[1]); w.y = pk2(vr[2], vr[3]); w.z = pk2(vr[4], vr[5]); w.w = pk2(vr[6], vr[7]); *(u32x4*)d0 = w;
        w.x = pk2(vr[8], vr[9]); w.y = pk2(vr[10], vr[11]); w.z = pk2(vr[12], vr[13]); w.w = pk2(vr[14], vr[15]); *(u32x4*)(d0 + 8) = w;
        w.x = pk2(vi[0], vi[1]); w.y = pk2(vi[2], vi[3]); w.z = pk2(vi[4], vi[5]); w.w = pk2(vi[6], vi[7]); *(u32x4*)d1 = w;
        w.x = pk2(vi[8], vi[9]); w.y = pk2(vi[10], vi[11]); w.z = pk2(vi[12], vi[13]); w.w = pk2(vi[14], vi[15]); *(u32x4*)(d1 + 8) = w;
    }
    for (size_t i = gt; i < (size_t)32 * 128 * 64; i += NGT) {
        const int ch = (int)i & 63, rr = (int)(i >> 6), g = rr >> 7, n = 128 + (rr & 127);
        *(u32x4*)(wst + (size_t)(g * 256 + n) * 512 + ch * 8) = (u32x4){0u, 0u, 0u, 0u};
    }
    for (size_t i = gt; i < (size_t)32 * 512 * 64; i += NGT) {
        const int p = (int)i & 63, gn = (int)(i >> 6), g = gn >> 9, n = gn & 511, t = n >> 4, ho = n & 15, gp = g * 64 + p;
        const float dt = __expf(ldt[g]);
        const C2 cc = cmul(C2{cre[(size_t)(g * 16 + ho) * 64 + p], cim[(size_t)(g * 16 + ho) * 64 + p]}, s5_apow(lre[gp], lim[gp], dt, (float)(t + 1)));
        *(unsigned*)(wtz + (size_t)gn * 640 + 512 + 2 * p) = pk2(cc.r, -cc.i);
    }
    for (size_t i = gt; i < (size_t)32 * 512 * 32; i += NGT) {
        const int s = (int)i & 31, gn = (int)(i >> 5), t = (gn & 511) >> 4;
        if (s > t) { u32x4* d = (u32x4*)(wtz + (size_t)gn * 640 + s * 16); d[0] = (u32x4){0u, 0u, 0u, 0u}; d[1] = (u32x4){0u, 0u, 0u, 0u}; }
    }
    {
        LAS float* EA = (LAS float*)(lds + 69632);
        LAS float* Er = EA + 128; LAS float* Ei = Er + 1024;
        for (int it = wg; it < 1024; it += G) {
            const int g = it >> 5, tau = it & 31;
            __syncthreads();
            if (tid < 64) { const int gp = g * 64 + tid; const float dt = __expf(ldt[g]); const float lr = lre[gp], li = lim[gp];
                const C2 e = cmul(s5_apow(lr, li, dt, (float)tau), s5_zoh(lr, li, dt)); EA[2 * tid] = e.r; EA[2 * tid + 1] = e.i; }
            __syncthreads();
            for (int e = tid; e < 1024; e += 512) { const int p = e >> 4; const C2 v = cmul(C2{EA[2 * p], EA[2 * p + 1]}, C2{bre[(size_t)g * 1024 + e], bim[(size_t)g * 1024 + e]}); Er[e] = v.r; Ei[e] = v.i; }
            __syncthreads();
            if (tid < 256) {
                const int ho = tid >> 4, hi = tid & 15; const float* cr = cre + (size_t)(g * 16 + ho) * 64; const float* ci = cim + (size_t)(g * 16 + ho) * 64;
                float acc = 0.f;
#pragma unroll 8
                for (int p = 0; p < 64; ++p) acc += cr[p] * Er[p * 16 + hi] - ci[p] * Ei[p * 16 + hi];
                const bf16_t kv = (bf16_t)(pk2(acc, acc) & 0xffffu);
                for (int t = tau; t < 32; ++t) wtz[(size_t)(g * 512 + t * 16 + ho) * 640 + (t - tau) * 16 + hi] = kv;
            }
        }
        __syncthreads();
    }
}

__device__ __forceinline__ int attn_item(int it, int G, int wg) {
    if (G == 256) { if (it < 7) return it * 256 + wg; if (wg >= 128 && it < 9) return 1792 + (it - 7) * 128 + (wg - 128); return -1; }
    const int item = it * G + wg; return item < 2048 ? item : -1;
}
__device__ __forceinline__ void phase_attn(const Args& a, LAS unsigned char* lds, int wg, int G) {
    const int tid = threadIdx.x, lane = tid & 63, wid = __builtin_amdgcn_readfirstlane(tid >> 6), fr = lane & 15, fq = lane >> 4, hsel = wid >> 2;
    const bf16_t* qb_ = (const bf16_t*)(a.ws + WS_Q); const bf16_t* kb_ = (const bf16_t*)(a.ws + WS_K); const bf16_t* vb_ = (const bf16_t*)(a.ws + WS_V);
    bf16_t* mixed = (bf16_t*)(a.ws + WS_MIXED);
    LAS int* flags = (LAS int*)(lds + 73728);
    f16x8 mka, mkb, ones;
#pragma unroll
    for (int j = 0; j < 8; ++j) { const int kl = 16 * (j >> 2) + 4 * fq + (j & 3); mka[j] = (kl > fr) ? (_Float16)1.0f : (_Float16)0.0f; mkb[j] = (kl > 16 + fr) ? (_Float16)1.0f : (_Float16)0.0f; ones[j] = (_Float16)1.0f; }
    const int r_st = tid >> 3, c8_st = (tid & 7) * 8;
    int item = attn_item(0, G, wg);
    bf16x8 qf[2]; u32x4 kreg0, vreg0, kreg1, vreg1;
    if (item >= 0) { const int qblk = 63 - (item >> 5), bhp = item & 31, bh0 = (bhp >> 2) * 8 + (bhp & 3) * 2; const size_t h0 = (size_t)bh0 * 4096 * 64, hm = h0 + (size_t)hsel * 4096 * 64;
        const int qrow = qblk * 64 + (wid & 3) * 16 + fr, kt = qblk;
        qf[0] = *(const bf16x8*)(qb_ + hm + (size_t)qrow * 64 + fq * 8); qf[1] = *(const bf16x8*)(qb_ + hm + (size_t)qrow * 64 + 32 + fq * 8);
        kreg0 = *(const u32x4*)(kb_ + h0 + (size_t)(kt * 64 + r_st) * 64 + c8_st); vreg0 = *(const u32x4*)(vb_ + h0 + (size_t)(kt * 64 + r_st) * 64 + c8_st);
        kreg1 = *(const u32x4*)(kb_ + h0 + (size_t)(4096 + kt * 64 + r_st) * 64 + c8_st); vreg1 = *(const u32x4*)(vb_ + h0 + (size_t)(4096 + kt * 64 + r_st) * 64 + c8_st); }
    for (int it = 0; item >= 0; ++it) {
        const int nitem = attn_item(it + 1, G, wg);
        bf16x8 nqf[2]; u32x4 nk0, nv0, nk1, nv1;
        if (nitem >= 0) { const int qblk = 63 - (nitem >> 5), bhp = nitem & 31, bh0 = (bhp >> 2) * 8 + (bhp & 3) * 2; const size_t h0 = (size_t)bh0 * 4096 * 64, hm = h0 + (size_t)hsel * 4096 * 64;
            const int qrow = qblk * 64 + (wid & 3) * 16 + fr, kt = qblk;
            nqf[0] = *(const bf16x8*)(qb_ + hm + (size_t)qrow * 64 + fq * 8); nqf[1] = *(const bf16x8*)(qb_ + hm + (size_t)qrow * 64 + 32 + fq * 8);
            nk0 = *(const u32x4*)(kb_ + h0 + (size_t)(kt * 64 + r_st) * 64 + c8_st); nv0 = *(const u32x4*)(vb_ + h0 + (size_t)(kt * 64 + r_st) * 64 + c8_st);
            nk1 = *(const u32x4*)(kb_ + h0 + (size_t)(4096 + kt * 64 + r_st) * 64 + c8_st); nv1 = *(const u32x4*)(vb_ + h0 + (size_t)(4096 + kt * 64 + r_st) * 64 + c8_st); }
        const int qblk = 63 - (item >> 5), bhp = item & 31, bh0 = (bhp >> 2) * 8 + (bhp & 3) * 2, bh = bh0 + hsel;
        const bf16_t* kp = kb_ + (size_t)bh0 * 4096 * 64; const bf16_t* vp = vb_ + (size_t)bh0 * 4096 * 64;
        const int qmin = qblk * 64 + (wid & 3) * 16, qrow = qmin + fr;
        f32x4 o[4];
#pragma unroll
        for (int d = 0; d < 4; ++d) o[d] = (f32x4){0.f, 0.f, 0.f, 0.f};
        float carry = 0.f;
        if (tid < 16) flags[tid] = 0;
        int buf = 0;
        for (int kt = qblk; kt >= 0; --kt) {
            LAS bf16_t* Ks = (LAS bf16_t*)(lds + (buf * 2 + hsel) * 18432);
            LAS bf16_t* Vt = Ks + 64 * 72;
            {
                LAS bf16_t* K0 = (LAS bf16_t*)(lds + (buf * 2) * 18432); LAS bf16_t* V0 = K0 + 64 * 72; LAS bf16_t* K1 = K0 + 9216; LAS bf16_t* V1 = K1 + 64 * 72;
                *(LAS u32x4*)(K0 + r_st * 72 + c8_st) = kreg0; *(LAS u32x4*)(K1 + r_st * 72 + c8_st) = kreg1;
                V0[(c8_st + 0) * 72 + r_st] = (bf16_t)(vreg0.x & 0xffffu); V0[(c8_st + 1) * 72 + r_st] = (bf16_t)(vreg0.x >> 16);
                V0[(c8_st + 2) * 72 + r_st] = (bf16_t)(vreg0.y & 0xffffu); V0[(c8_st + 3) * 72 + r_st] = (bf16_t)(vreg0.y >> 16);
                V0[(c8_st + 4) * 72 + r_st] = (bf16_t)(vreg0.z & 0xffffu); V0[(c8_st + 5) * 72 + r_st] = (bf16_t)(vreg0.z >> 16);
                V0[(c8_st + 6) * 72 + r_st] = (bf16_t)(vreg0.w & 0xffffu); V0[(c8_st + 7) * 72 + r_st] = (bf16_t)(vreg0.w >> 16);
                V1[(c8_st + 0) * 72 + r_st] = (bf16_t)(vreg1.x & 0xffffu); V1[(c8_st + 1) * 72 + r_st] = (bf16_t)(vreg1.x >> 16);
                V1[(c8_st + 2) * 72 + r_st] = (bf16_t)(vreg1.y & 0xffffu); V1[(c8_st + 3) * 72 + r_st] = (bf16_t)(vreg1.y >> 16);
                V1[(c8_st + 4) * 72 + r_st] = (bf16_t)(vreg1.z & 0xffffu); V1[(c8_st + 5) * 72 + r_st] = (bf16_t)(vreg1.z >> 16);
                V1[(c8_st + 6) * 72 + r_st] = (bf16_t)(vreg1.w & 0xffffu); V1[(c8_st + 7) * 72 + r_st] = (bf16_t)(vreg1.w >> 16);
            }
            __syncthreads();
            { int alld = 1;
#pragma unroll
              for (int w = 0; w < 8; ++w) alld &= flags[(buf ^ 1) * 8 + w];
              if (alld) break; }
            if (kt > 0) {
                kreg0 = *(const u32x4*)(kp + (size_t)((kt - 1) * 64 + r_st) * 64 + c8_st); vreg0 = *(const u32x4*)(vp + (size_t)((kt - 1) * 64 + r_st) * 64 + c8_st);
                kreg1 = *(const u32x4*)(kp + (size_t)(4096 + (kt - 1) * 64 + r_st) * 64 + c8_st); vreg1 = *(const u32x4*)(vp + (size_t)(4096 + (kt - 1) * 64 + r_st) * 64 + c8_st);
            }
            const int key0 = kt * 64;
            int wdone = 0;
            if (key0 < qmin + 15) {
                f32x4 s[4];
#pragma unroll
                for (int n = 0; n < 4; ++n) { s[n] = (f32x4){0.f, 0.f, 0.f, 0.f};
#pragma unroll
                    for (int kk = 0; kk < 2; ++kk) { const bf16x8 kf = *(const LAS bf16x8*)(Ks + (n * 16 + fr) * 72 + kk * 32 + fq * 8); s[n] = __builtin_amdgcn_mfma_f32_16x16x32_bf16(kf, qf[kk], s[n], 0, 0, 0); } }
                const bool diag = (key0 + 63) >= qmin;
                f32x4 l1[4];
                if (diag) {
#pragma unroll
                    for (int n = 0; n < 4; ++n)
#pragma unroll
                        for (int j = 0; j < 4; ++j) { const float z = s[n][j]; const bool valid = (key0 + 16 * n + 4 * fq + j) < qrow;
                            const float sp = fmaxf(z, 0.f) + __builtin_amdgcn_logf(1.0f + __builtin_amdgcn_exp2f(-fabsf(z)));
                            l1[n][j] = valid ? -sp : 0.f; }
                } else {
#pragma unroll
                    for (int n = 0; n < 4; ++n)
#pragma unroll
                        for (int j = 0; j < 4; ++j) { const float z = s[n][j]; l1[n][j] = -(fmaxf(z, 0.f) + __builtin_amdgcn_logf(1.0f + __builtin_amdgcn_exp2f(-fabsf(z)))); }
                }
                f16x8 y0, y1;
#pragma unroll
                for (int j = 0; j < 4; ++j) { y0[j] = (_Float16)l1[0][j]; y0[4 + j] = (_Float16)l1[1][j]; y1[j] = (_Float16)l1[2][j]; y1[4 + j] = (_Float16)l1[3][j]; }
                f32x4 tl[4];
                const f32x4 z4 = (f32x4){0.f, 0.f, 0.f, 0.f};
                tl[0] = __builtin_amdgcn_mfma_f32_16x16x32_f16(mka, y0, z4, 0, 0, 0); tl[0] = __builtin_amdgcn_mfma_f32_16x16x32_f16(ones, y1, tl[0], 0, 0, 0);
                tl[1] = __builtin_amdgcn_mfma_f32_16x16x32_f16(mkb, y0, z4, 0, 0, 0); tl[1] = __builtin_amdgcn_mfma_f32_16x16x32_f16(ones, y1, tl[1], 0, 0, 0);
                tl[2] = __builtin_amdgcn_mfma_f32_16x16x32_f16(mka, y1, z4, 0, 0, 0);
                tl[3] = __builtin_amdgcn_mfma_f32_16x16x32_f16(mkb, y1, z4, 0, 0, 0);
                const float tot = __shfl(tl[0][0] + l1[0][0], fr);
                f32x4 w[4];
                if (diag) {
#pragma unroll
                    for (int n = 0; n < 4; ++n)
#pragma unroll
                        for (int j = 0; j < 4; ++j) { const bool valid = (key0 + 16 * n + 4 * fq + j) < qrow;
                            w[n][j] = valid ? __builtin_amdgcn_exp2f(s[n][j] + l1[n][j] + tl[n][j] + carry) : 0.f; }
                } else {
#pragma unroll
                    for (int n = 0; n < 4; ++n)
#pragma unroll
                        for (int j = 0; j < 4; ++j) w[n][j] = __builtin_amdgcn_exp2f(s[n][j] + l1[n][j] + tl[n][j] + carry);
                }
                carry += tot;
                bf16x8 wf[2];
#pragma unroll
                for (int P = 0; P < 2; ++P) { u32x4 t4; t4.x = pk2(w[2 * P][0], w[2 * P][1]); t4.y = pk2(w[2 * P][2], w[2 * P][3]); t4.z = pk2(w[2 * P + 1][0], w[2 * P + 1][1]); t4.w = pk2(w[2 * P + 1][2], w[2 * P + 1][3]); wf[P] = __builtin_bit_cast(bf16x8, t4); }
#pragma unroll
                for (int d = 0; d < 4; ++d)
#pragma unroll
                    for (int P = 0; P < 2; ++P) {
                        const LAS bf16_t* vr = Vt + (d * 16 + fr) * 72 + 32 * P + 4 * fq;
                        u32x4 t4; const u32x2 lo = *(const LAS u32x2*)vr, hi = *(const LAS u32x2*)(vr + 16); t4.x = lo.x; t4.y = lo.y; t4.z = hi.x; t4.w = hi.y;
                        o[d] = __builtin_amdgcn_mfma_f32_16x16x32_bf16(__builtin_bit_cast(bf16x8, t4), wf[P], o[d], 0, 0, 0);
                    }
                wdone = __all(carry < SB_EXIT) ? 1 : 0;
            }
            if (lane == 0) flags[buf * 8 + wid] = wdone;
            buf ^= 1;
        }
        { bf16_t* dst = mixed + (size_t)((bh >> 3) * 4096 + qrow) * 1024 + 512 + (bh & 7) * 64 + 4 * fq;
#pragma unroll
          for (int d = 0; d < 4; ++d) *(u32x2*)(dst + 16 * d) = pk4(o[d]); }
        __syncthreads();
        item = nitem;
        if (nitem >= 0) { qf[0] = nqf[0]; qf[1] = nqf[1]; kreg0 = nk0; vreg0 = nv0; kreg1 = nk1; vreg1 = nv1; }
    }
}

__device__ __forceinline__ void scan_unit(const Args& a, LAS unsigned char* lds, int pm) {
    const float* sloc = (const float*)(a.ws + WS_SLOC) + (size_t)pm * 256 * 128; bf16_t* ucat = (bf16_t*)(a.ws + WS_UCAT); const float* at = (const float*)(a.ws + WS_AT);
    const int tid = threadIdx.x;
    LAS f32x4* L4 = (LAS f32x4*)lds;
#pragma unroll 4
    for (int i = tid; i < 8192; i += 512) L4[i] = *(const f32x4*)(sloc + (size_t)i * 4);
    __syncthreads();
    if (tid < 128) {
        const int p = tid & 63, bs = tid >> 6, g = pm >> 2;
        const float ar = at[2 * (g * 64 + p)], ai = at[2 * (g * 64 + p) + 1];
        float xr = 0.f, xi = 0.f;
        const LAS float* Ls = (const LAS float*)lds + (bs * 128) * 128 + 2 * p;
        bf16_t* up = ucat + ((size_t)pm * 256 + bs * 128) * 640 + 512 + 2 * p;
#pragma unroll 4
        for (int sc = 0; sc < 128; ++sc) {
            *(unsigned*)(up + (size_t)sc * 640) = pk2(xr, xi);
            const float sr = Ls[sc * 128], si = Ls[sc * 128 + 1];
            const float nr = ar * xr - ai * xi + sr, ni = ar * xi + ai * xr + si; xr = nr; xi = ni;
        }
    }
    asm volatile("s_waitcnt vmcnt(0)" ::: "memory");
    __syncthreads();
}

__device__ __forceinline__ void pool_run(const Args& a, int g, int b, int run, int lane) {
    const bf16_t* h = (const bf16_t*)a.out; const float* ss3 = (const float*)(a.ws + WS_SS) + 3 * MTOK; bf16_t* yp = (bf16_t*)(a.ws + WS_YP);
    const int w = 2 << g, t0 = run * 32;
    const bf16_t* hp = h + (size_t)b * 4096 * 1024 + g * 256 + lane * 4; const float* sp = ss3 + b * 4096;
    f32x4 s = (f32x4){0.f, 0.f, 0.f, 0.f};
    for (int t = t0 - w + 1; t < t0; ++t) if (t >= 0) s += unpk4(*(const u32x2*)(hp + (size_t)t * 1024)) * rsqrtf(sp[t] * (1.0f / 1024.0f) + EPS);
#pragma unroll 4
    for (int t = t0; t < t0 + 32; ++t) {
        const f32x4 cur = unpk4(*(const u32x2*)(hp + (size_t)t * 1024)) * rsqrtf(sp[t] * (1.0f / 1024.0f) + EPS);
        s += cur;
        const float inv = 1.0f / (float)((t + 1) < w ? (t + 1) : w);
        *(u32x2*)(yp + ((size_t)g * MTOK + b * 4096 + t) * 256 + lane * 4) = pk4(s * inv - cur);
        const int told = t - w + 1;
        if (told >= 0) s -= unpk4(*(const u32x2*)(hp + (size_t)told * 1024)) * rsqrtf(sp[told] * (1.0f / 1024.0f) + EPS);
    }
}

#define XB_TMO      128
#define XB_XCNT(j)  (256  + 64 * (j))
#define XB_XSUB(j)  (1280 + 64 * (j))
#define XB_XGEN(j)  (2304 + 64 * (j))
#define XB_TOP      3328
#define XB_TOPGEN   3392
#define XCD_BAR_WORDS 3456
#define XB_SPIN_CAP (1u << 20)
__device__ __forceinline__ unsigned xb_ld(unsigned* p)              { return __hip_atomic_load(p, __ATOMIC_RELAXED, __HIP_MEMORY_SCOPE_AGENT); }
__device__ __forceinline__ unsigned xb_add(unsigned* p, unsigned v) { return __hip_atomic_fetch_add(p, v, __ATOMIC_RELAXED, __HIP_MEMORY_SCOPE_AGENT); }
__device__ __forceinline__ unsigned xb_xcc_id() { return (unsigned)__builtin_amdgcn_s_getreg((3 << 11) | 20) & 0xFu; }
#define XB_SPIN(cond, bar) do { unsigned _sp = 0; while (cond) { __builtin_amdgcn_s_sleep(1); \
    if ((++_sp & 255u) == 0u) { if (xb_ld(&(bar)[XB_TMO])) break; if (_sp > XB_SPIN_CAP) { atomicAdd(&(bar)[XB_TMO], 1u); break; } } } } while (0)
struct XcdBarrier { unsigned* bar; unsigned x; volatile LAS unsigned* st; };
__device__ __forceinline__ XcdBarrier xcd_barrier_post(unsigned* bar, volatile LAS unsigned* st) {
    XcdBarrier b; b.bar = bar; b.x = xb_xcc_id(); b.st = st;
    if (threadIdx.x == 0) (void)xb_add(&bar[XB_XCNT(b.x)], 1u);
    return b;
}
__device__ __forceinline__ void xcd_barrier_complete(unsigned* bar, unsigned x, unsigned& nloc, unsigned& nx) {
    const unsigned G = gridDim.x * gridDim.y * gridDim.z;
    unsigned sum, cnt, mine, sp = 0u;
    for (;;) {
        sum = 0u; cnt = 0u; mine = 0u;
#pragma unroll
        for (unsigned j = 0; j < 16; ++j) { const unsigned c = xb_ld(&bar[XB_XCNT(j)]); sum += c; cnt += (c > 0u) ? 1u : 0u; mine = (j == x) ? c : mine; }
        if (sum == G) break;
        __builtin_amdgcn_s_sleep(1);
        if ((++sp & 255u) == 0u) { if (xb_ld(&bar[XB_TMO])) break; if (sp > XB_SPIN_CAP) { atomicAdd(&bar[XB_TMO], 1u); break; } }
    }
    nloc = mine > 0u ? mine : 1u; nx = cnt > 0u ? cnt : 1u;
}
__device__ __forceinline__ void xcd_barrier(const XcdBarrier& b) {
    asm volatile("s_waitcnt vmcnt(0)" ::: "memory");
    __syncthreads();
    if (threadIdx.x == 0) {
        unsigned* bar = b.bar;
        __builtin_amdgcn_s_waitcnt(0);
        unsigned nloc = b.st[0], nx = b.st[1];
        if (nloc == 0u) { xcd_barrier_complete(bar, b.x, nloc, nx); b.st[0] = nloc; b.st[1] = nx; }
        const unsigned old = xb_add(&bar[XB_XSUB(b.x)], 1u);
        const unsigned gen = old / nloc;
        if (old + 1u == (gen + 1u) * nloc) {
            __builtin_amdgcn_fence(__ATOMIC_RELEASE, "agent");
            asm volatile("s_waitcnt vmcnt(0)" ::: "memory");
            const unsigned og = xb_add(&bar[XB_TOP], 1u);
            const unsigned tg = og / nx;
            if (og + 1u == (tg + 1u) * nx) xb_add(&bar[XB_TOPGEN], 1u);
            else XB_SPIN(xb_ld(&bar[XB_TOPGEN]) == tg, bar);
            __builtin_amdgcn_fence(__ATOMIC_ACQUIRE, "agent");
            xb_add(&bar[XB_XGEN(b.x)], 1u);
            asm volatile("s_waitcnt vmcnt(0)" ::: "memory");
        } else {
            XB_SPIN(xb_ld(&bar[XB_XGEN(b.x)]) == gen, bar);
            __builtin_amdgcn_fence(__ATOMIC_ACQUIRE, "agent");
            asm volatile("s_waitcnt vmcnt(0)" ::: "memory");
        }
    }
    __syncthreads();
}

__global__ void __launch_bounds__(512, 2) fwd_kernel(Args a) {
    extern __shared__ __attribute__((aligned(16))) unsigned char lds_raw[];
    LAS unsigned char* lds = (LAS unsigned char*)lds_raw;
    cg::grid_group grid = cg::this_grid();
    const int G = gridDim.x, wg = blockIdx.x;
    unsigned char* ws = a.ws;
    float* ssb = (float*)(ws + WS_SS);
    bf16_t* hb = (bf16_t*)(ws + WS_HB); bf16_t* eb = (bf16_t*)(ws + WS_EB);
    const int lo = a.ph_lo, hi = a.ph_hi;
#define IN(k) (PH_ON(k) && lo <= (k) && (k) < hi)
#define SEAM(k) do { if (lo <= (k) && (k) + 1 < hi) xcd_barrier(xbar); } while (0)
    if (threadIdx.x < 16) ((LAS unsigned*)(lds + 131072))[threadIdx.x] = 0u;
    __syncthreads();
    XcdBarrier xbar = xcd_barrier_post((unsigned*)(ws + WS_BAR), (volatile LAS unsigned*)(lds + 131072));
    if (hi > 1000) grid.sync();
    if (IN(0)) phase_prep(a, lds, wg, G);
    SEAM(0);
    if (IN(1)) {
        pg8::Gemm g{(const bf16_t*)a.out + (size_t)MTOK * 1024, (const bf16_t*)(ws + WS_WIN), 1024, 1024}; pg8::StaticOrder S; S.init(MTOK, 2048, G, wg);
        EpiIn E{ssb, (bf16_t*)(ws + WS_UCAT), (bf16_t*)(ws + WS_Q), (bf16_t*)(ws + WS_K), (bf16_t*)(ws + WS_V), a.in[I_QG], a.in[I_KG]};
        pg8::gemm_phase(lds, g, S, E);
    }
    SEAM(1);
    if (IN(2)) {
        unsigned* fl = (unsigned*)(ws + WS_BAR) + XCD_BAR_WORDS;
        {
            pg8::Gemm g{(const bf16_t*)(ws + WS_UCAT), (const bf16_t*)(ws + WS_WST), 640, 512}; pg8::OrderS S{G, wg};
            EpiS E{(float*)(ws + WS_SLOC)};
            pg8::gemm_phase(lds, g, S, E);
            for (int pm = wg; pm < 128; pm += G) {
                scan_unit(a, lds, pm);
                if (threadIdx.x == 0) { __builtin_amdgcn_fence(__ATOMIC_RELEASE, "agent"); asm volatile("s_waitcnt vmcnt(0)" ::: "memory"); __hip_atomic_store(fl + pm, 1u, __ATOMIC_RELAXED, __HIP_MEMORY_SCOPE_AGENT); }
            }
        }
        phase_attn(a, lds, wg, G);
        {
            if (threadIdx.x == 0) {
                for (int L = wg; L < 256; L += G) XB_SPIN(xb_ld(fl + (L >> 1)) < 1u, (unsigned*)(ws + WS_BAR));
                __builtin_amdgcn_fence(__ATOMIC_ACQUIRE, "agent"); asm volatile("s_waitcnt vmcnt(0)" ::: "memory");
            }
            __syncthreads();
            pg8::Gemm g{(const bf16_t*)(ws + WS_UCAT), (const bf16_t*)(ws + WS_WTZ), 640, 640}; pg8::OrderY S{G, wg};
            EpiY E{(const bf16_t*)(ws + WS_UCAT), a.in[I_D], (bf16_t*)(ws + WS_YBUF)};
            pg8::gemm_phase(lds, g, S, E);
            asm volatile("s_waitcnt vmcnt(0)" ::: "memory");
            __syncthreads();
            if (threadIdx.x == 0) { __builtin_amdgcn_fence(__ATOMIC_RELEASE, "agent"); asm volatile("s_waitcnt vmcnt(0)" ::: "memory");
                for (int L = wg; L < 256; L += G) xb_add(fl + 128 + 64 * ((L >> 1) & 3), 1u); }
        }
        {
            pg8::Gemm g{(const bf16_t*)(ws + WS_YBUF), (const bf16_t*)(ws + WS_WGLU), 512, 512}; pg8::StaticOrder S; S.init(MTOK, 512, G, wg);
            if (threadIdx.x == 0) {
                for (int j = 0; j < 4; ++j) XB_SPIN(xb_ld(fl + 128 + 64 * j) < 64u, (unsigned*)(ws + WS_BAR));
                __builtin_amdgcn_fence(__ATOMIC_ACQUIRE, "agent"); asm volatile("s_waitcnt vmcnt(0)" ::: "memory");
            }
            __syncthreads();
            EpiGlu E{(const bf16_t*)(ws + WS_YBUF), (bf16_t*)(ws + WS_MIXED)};
            pg8::gemm_phase(lds, g, S, E);
        }
    }
    SEAM(5);
    if (IN(6)) {
        pg8::Gemm g{(const bf16_t*)(ws + WS_MIXED), (const bf16_t*)(ws + WS_WOUT), 1024, 1024}; pg8::StaticOrder S; S.init(MTOK, 1024, G, wg);
        EpiRes<1> E{(const bf16_t*)a.out + (size_t)MTOK * 1024, hb, ssb + 1 * MTOK, nullptr};
        pg8::gemm_phase(lds, g, S, E);
    }
    SEAM(6);
#define MLP_UP(ph, li, ssi) if (IN(ph)) { \
        pg8::Gemm g{hb, (const bf16_t*)(ws + WS_WUP) + (size_t)(li) * 4096 * 1024, 1024, 1024}; pg8::StaticOrder S; S.init(MTOK, 4096, G, wg); \
        EpiUp E{ssb + (ssi) * MTOK, (bf16_t*)(ws + WS_HID)}; \
        pg8::gemm_phase(lds, g, S, E); }
#define MLP_DOWN(ph, li, ssi) if (IN(ph)) { \
        { pg8::Gemm g{(const bf16_t*)(ws + WS_HID), (const bf16_t*)(ws + WS_WDOWN) + (size_t)(li) * 1024 * 4096, 4096, 4096}; pg8::StaticOrder S; S.init(MTOK, 1024, G, wg, 1); \
          EpiRes<1> E{hb, hb, ssb + (ssi) * MTOK, nullptr}; \
          pg8::gemm_phase(lds, g, S, E); } \
        { int ke = 256; asm volatile("" : "+s"(ke)); pg8::Gemm g{(const bf16_t*)(ws + WS_PB) + (size_t)(li) * MTOK * 256, (const bf16_t*)(ws + WS_WPLE) + (size_t)(li) * 1024 * 256, ke, ke}; pg8::StaticOrder S; S.init(MTOK, 1024, G, wg); \
          EpiE E{eb}; \
          pg8::gemm_phase(lds, g, S, E); } }
#define PLE_GATE(ph, li, ssi, sso, FIN) if (IN(ph)) { \
        pg8::Gemm g{hb, (const bf16_t*)(ws + WS_WGATE) + (size_t)(li) * 1024 * 1024, 1024, 1024}; pg8::StaticOrder S; S.init(MTOK, 1024, G, wg); \
        EpiGate<FIN> E{hb, a.out, (bf16_t*)a.out, eb, ssb + (ssi) * MTOK, (sso)}; \
        pg8::gemm_phase(lds, g, S, E); }
    MLP_UP(7, 0, 1)
    SEAM(7);
    MLP_DOWN(8, 0, 2)
    SEAM(8);
    PLE_GATE(9, 0, 2, ssb + 3 * MTOK, false)
    SEAM(9);
    if (IN(11)) {
        for (int L = wg; L < 512; L += G) { const int pmr = L & 127; pool_run(a, L >> 7, pmr >> 4, (pmr & 15) * 8 + (int)(threadIdx.x >> 6), (int)(threadIdx.x & 63)); }
        asm volatile("s_waitcnt vmcnt(0)" ::: "memory"); __syncthreads();
        int kp = 256; asm volatile("" : "+s"(kp));
        pg8::Gemm g{(const bf16_t*)(ws + WS_YP), (const bf16_t*)(ws + WS_WPOOL), kp, kp}; pg8::OrderP S{G, wg};
        EpiRes<2> E{(const bf16_t*)a.out, hb, ssb + 4 * MTOK, a.in[I_POOLS]};
        pg8::gemm_phase(lds, g, S, E);
    }
    SEAM(11);
    MLP_UP(12, 1, 4)
    SEAM(12);
    MLP_DOWN(13, 1, 5)
    SEAM(13);
    PLE_GATE(14, 1, 5, (float*)nullptr, true)
}

extern "C" void kernel_launch(void* const* d_in, const int* in_sizes, int n_in, void* d_out, int out_size, void* d_ws, size_t ws_size, hipStream_t stream) {
    static int inited = 0;
    if (!inited) {
        if (n_in != 25 || ws_size < WS_END) { fprintf(stderr, "kernel_launch: unexpected n_in %d / ws_size %zu (need %zu)\n", n_in, ws_size, (size_t)WS_END); }
        hipFuncSetAttribute((const void*)fwd_kernel, hipFuncAttributeMaxDynamicSharedMemorySize, LDS_BYTES);
        inited = 1;
    }
    (void)hipMemsetAsync((unsigned char*)d_ws + WS_BAR, 0, (XCD_BAR_WORDS + 512) * 4, stream);
    Args a{};
    for (int i = 0; i < 25; ++i) a.in[i] = (const float*)d_in[i];
    a.out = (float*)d_out; a.ws = (unsigned char*)d_ws;
    a.ph_lo = 0; a.ph_hi = NPHASE;
    void* args[] = {&a};
    hipError_t e = hipLaunchCooperativeKernel((const void*)fwd_kernel, dim3(256), dim3(512), args, LDS_BYTES, stream);
    if (e != hipSuccess) fprintf(stderr, "cooperative launch failed: %s\n", hipGetErrorString(e));
}
```

```cpp
#include <hip/hip_runtime.h>
#include <hip/hip_cooperative_groups.h>
#include <cstdio>
namespace cg = cooperative_groups;

#define LAS __attribute__((address_space(3)))
typedef unsigned short bf16_t;
typedef short bf16x8 __attribute__((ext_vector_type(8)));
typedef _Float16 f16x8 __attribute__((ext_vector_type(8)));
typedef float f32x4 __attribute__((ext_vector_type(4)));
typedef unsigned u32x4 __attribute__((ext_vector_type(4)));
typedef unsigned u32x2 __attribute__((ext_vector_type(2)));

constexpr int MTOK = 32768, DM = 1024, SEQ = 4096, NBATCH = 8;
constexpr float EPS = 1e-6f;
constexpr int NPHASE = 15;
#ifndef PHMASK
#define PHMASK 0x7fff
#endif
#define PH_ON(k) ((PHMASK >> (k)) & 1)
constexpr int LDS_BYTES = 131072 + 64;
constexpr float SB_EXIT = -40.0f * 1.44269504089f;

constexpr size_t MiB = 1048576;
constexpr size_t WS_WIN = 0;
constexpr size_t WS_WGLU = WS_WIN + 4 * MiB;
constexpr size_t WS_WOUT = WS_WGLU + MiB / 2;
constexpr size_t WS_WUP = WS_WOUT + 2 * MiB;
constexpr size_t WS_WDOWN = WS_WUP + 16 * MiB;
constexpr size_t WS_WGATE = WS_WDOWN + 16 * MiB;
constexpr size_t WS_WPLE = WS_WGATE + 4 * MiB;
constexpr size_t WS_WPOOL = WS_WPLE + MiB;
constexpr size_t WS_WST = WS_WPOOL + MiB / 2;
constexpr size_t WS_WTZ = WS_WST + 8 * MiB;
constexpr size_t WS_AT = WS_WTZ + 20 * MiB;
constexpr size_t WS_BAR = WS_AT + 65536;
constexpr size_t WS_SS = WS_AT + MiB / 4;
constexpr size_t WS_PB = WS_SS + MiB;
constexpr size_t WS_HB = WS_PB + 32 * MiB;
constexpr size_t WS_EB = WS_HB + 64 * MiB;
constexpr size_t WS_R1 = WS_EB + 64 * MiB;
constexpr size_t WS_XB = WS_R1;
constexpr size_t WS_MIXED = WS_R1;
constexpr size_t WS_UCAT = WS_R1 + 64 * MiB;
constexpr size_t WS_Q = WS_UCAT + 40 * MiB;
constexpr size_t WS_K = WS_Q + 32 * MiB;
constexpr size_t WS_V = WS_K + 32 * MiB;
constexpr size_t WS_YBUF = WS_V + 32 * MiB;
constexpr size_t WS_SLOC = WS_YBUF + 32 * MiB;
constexpr size_t WS_HID = WS_R1;
constexpr size_t WS_YP = WS_R1;
constexpr size_t WS_END = WS_R1 + 256 * MiB;

__device__ __forceinline__ unsigned pk2(float lo, float hi) { unsigned r; asm("v_cvt_pk_bf16_f32 %0, %1, %2" : "=v"(r) : "v"(lo), "v"(hi)); return r; }
__device__ __forceinline__ float bf2f(unsigned short b) { return __uint_as_float(((unsigned)b) << 16); }
__device__ __forceinline__ float bflo(unsigned w) { return __uint_as_float(w << 16); }
__device__ __forceinline__ float bfhi(unsigned w) { return __uint_as_float(w & 0xffff0000u); }
__device__ __forceinline__ u32x2 pk4(f32x4 v) { u32x2 w; w.x = pk2(v[0], v[1]); w.y = pk2(v[2], v[3]); return w; }
__device__ __forceinline__ f32x4 unpk4(u32x2 w) { return (f32x4){bflo(w.x), bfhi(w.x), bflo(w.y), bfhi(w.y)}; }
__device__ __forceinline__ u32x4 pk8(f32x4 a, f32x4 b) { u32x4 w; w.x = pk2(a[0], a[1]); w.y = pk2(a[2], a[3]); w.z = pk2(b[0], b[1]); w.w = pk2(b[2], b[3]); return w; }
__device__ __forceinline__ f32x4 unpk8lo(u32x4 w) { return (f32x4){bflo(w.x), bfhi(w.x), bflo(w.y), bfhi(w.y)}; }
__device__ __forceinline__ f32x4 unpk8hi(u32x4 w) { return (f32x4){bflo(w.z), bfhi(w.z), bflo(w.w), bfhi(w.w)}; }
__device__ __forceinline__ float sigmoidf_(float z) { return __builtin_amdgcn_rcpf(1.0f + __expf(-z)); }

namespace pg8 {
constexpr int BM = 256, BK = 64, HALF = 128, HTB = HALF * BK * 2, STAGE_BYTES = 8 * HTB, NXCD = 8, WGM = 2;
__host__ __device__ __forceinline__ int lds_byte(int r, int c) { const int st = (r >> 4) * 2 + (c >> 5), rr = r & 15, cc = c & 31, ob = rr * 64 + cc * 2; return st * 1024 + (ob ^ (((ob >> 9) & 1) << 5)); }
__host__ __device__ __forceinline__ void stage_rc(int b, int& R, int& C) { const int st = b / 1024, sb = b % 1024, swz = sb ^ (((sb >> 9) & 1) << 5); R = (st >> 1) * 16 + swz / 64; C = (st & 1) * 32 + (swz % 64) / 2; }
__host__ __device__ __forceinline__ int perm32(int rho) { const int n = rho >> 4, i = rho & 15; return 8 * (i >> 2) + 4 * n + (i & 3); }
struct Unit { int pm, pn; };
struct Gemm { const bf16_t* A; const bf16_t* Bt; int lda, K; };

struct StaticOrder {
    __device__ bool next_skip(int, Unit&) const { return false; }
    int nM, nN, nwg, G, c, rev;
    __device__ void init(int M, int N, int G_, int c_, int rev_ = 0) { nM = M / BM; nN = N / BM; nwg = nM * nN; G = G_; c = c_; rev = rev_; }
    __device__ bool next(int i, Unit& u) const {
        const int nr = (nwg + G - 1) / G; if (i >= nr) return false;
        const long L = (long)(rev ? nr - 1 - i : i) * G + c; if (L >= nwg) return next_skip(i, u);
        int wgid = (int)L; { const int q = nwg / NXCD, r = nwg % NXCD, xcd = wgid % NXCD, off = wgid / NXCD; wgid = (xcd < r ? xcd * (q + 1) : r * (q + 1) + (xcd - r) * q) + off; }
        const int nig = WGM * nN, gid = wgid / nig, fm = gid * WGM, gsz = (nM - fm) < WGM ? (nM - fm) : WGM;
        u.pm = fm + ((wgid % nig) % gsz); u.pn = (wgid % nig) / gsz; return true;
    }
};
struct OrderS { int G, c; __device__ bool next(int i, Unit& u) const { const int L = i * G + c; if (L >= 128) return false; u.pm = L; u.pn = L >> 2; return true; } };
struct OrderY { int G, c; __device__ bool next(int i, Unit& u) const { const int L = i * G + c; if (L >= 256) return false; u.pm = L >> 1; u.pn = ((L >> 3) << 1) + (L & 1); return true; } };
struct OrderP { int G, c; __device__ bool next(int i, Unit& u) const { const int L = i * G + c; if (L >= 512) return false; u.pm = L; u.pn = L >> 7; return true; } };

template <class Epi, class Sched, bool SP2 = true, bool ALIGN_EPI = true>
__device__ __forceinline__ void gemm_phase(LAS unsigned char* lds, const Gemm g, const Sched& S, const Epi& E) {
    const int tid = threadIdx.x, wid = __builtin_amdgcn_readfirstlane(tid >> 6), lane = tid & 63, wr = wid >> 2, wc = wid & 3, fr = lane & 15, fq = lane >> 4;
    const int K = g.K, nt = K / BK;
    unsigned voffA[2], voffB[2];
#pragma unroll
    for (int i = 0; i < 2; ++i) { int R, C; stage_rc(tid * 16 + i * 8192, R, C);
        const int Rb = Epi::PERM ? ((R & ~31) + perm32(R & 31)) : R;
        voffA[i] = (unsigned)(R * g.lda + C) * 2u; voffB[i] = (unsigned)(Rb * K + C) * 2u; }
    const size_t kstep = (size_t)(BK * 2);
    const size_t hstepA = (size_t)HALF * g.lda * 2, hstepB = (size_t)HALF * K * 2;
    const size_t tstepA = 2 * hstepA, tstepB = 2 * hstepB;
    const unsigned ldsw = (unsigned)wid * 1024u;
    const int aoff = lds_byte(wr * 64 + fr, fq * 8), boff = lds_byte(wc * 32 + fr, fq * 8);
#define PG8_SA(b, h) (((b) * 2 + (h)) * HTB)
#define PG8_SB(b, h) ((4 + (b) * 2 + (h)) * HTB)
#define PG8_STAGE(bufoff, gbase, voff) do { _Pragma("unroll") for (int _i = 0; _i < 2; ++_i) \
        __builtin_amdgcn_global_load_lds((const unsigned*)((const char*)(gbase) + (voff)[_i]), (LAS unsigned*)(lds + (bufoff) + ldsw + _i * 8192), 16, 0, 0); } while (0)
#define PG8_LDA(dst, b, h) do { _Pragma("unroll") for (int m = 0; m < 4; ++m) _Pragma("unroll") for (int k = 0; k < 2; ++k) dst[m][k] = *(const LAS bf16x8*)(lds + PG8_SA(b, h) + aoff + m * 2048 + k * 1024); } while (0)
#define PG8_LDB(dst, b, h) do { _Pragma("unroll") for (int n = 0; n < 2; ++n) _Pragma("unroll") for (int k = 0; k < 2; ++k) dst[n][k] = *(const LAS bf16x8*)(lds + PG8_SB(b, h) + boff + n * 2048 + k * 1024); } while (0)
#define PG8_MMA(ai, bj, At, Bt) do { __builtin_amdgcn_s_setprio(1); _Pragma("unroll") for (int m = 0; m < 4; ++m) _Pragma("unroll") for (int n = 0; n < 2; ++n) _Pragma("unroll") for (int k = 0; k < 2; ++k) \
        acc[ai][bj][m][n] = __builtin_amdgcn_mfma_f32_16x16x32_bf16(Bt[n][k], At[m][k], acc[ai][bj][m][n], 0, 0, 0); __builtin_amdgcn_s_setprio(0); } while (0)
#define PG8_WAIT_V(n) asm volatile("s_waitcnt vmcnt(" #n ")" ::: "memory")
#define PG8_WAIT_L(n) asm volatile("s_waitcnt lgkmcnt(" #n ")" ::: "memory")
#define PG8_BAR __builtin_amdgcn_s_barrier()
#define PG8_SCHED __builtin_amdgcn_sched_barrier(0)
    Unit cur, nxt; int ui = 0;
    if (!S.next(0, cur)) return;
    typename Epi::Pre pre;
    constexpr bool HASPRE = sizeof(typename Epi::Pre) > 1;
    f32x4 acc[2][2][4][2];
#pragma unroll
    for (int a = 0; a < 2; ++a)
#pragma unroll
        for (int b = 0; b < 2; ++b)
#pragma unroll
            for (int m = 0; m < 4; ++m)
#pragma unroll
                for (int n = 0; n < 2; ++n) acc[a][b][m][n] = (f32x4){0.f, 0.f, 0.f, 0.f};
    bf16x8 At[4][2], B0[2][2], B1[2][2];
    const char* cA = (const char*)g.A + (size_t)cur.pm * tstepA; const char* cB = (const char*)g.Bt + (size_t)cur.pn * tstepB;
    if constexpr (SP2) {
        PG8_STAGE(PG8_SB(0, 0), cB, voffB); PG8_STAGE(PG8_SB(0, 1), cB + hstepB, voffB); PG8_STAGE(PG8_SA(0, 0), cA, voffA); PG8_STAGE(PG8_SA(0, 1), cA + hstepA, voffA);
        if (wr == 1) PG8_BAR;
        PG8_WAIT_V(2); PG8_BAR;
        PG8_STAGE(PG8_SB(1, 0), cB + kstep, voffB); PG8_STAGE(PG8_SA(1, 0), cA + kstep, voffA); PG8_STAGE(PG8_SB(1, 1), cB + hstepB + kstep, voffB);
        PG8_WAIT_V(6); PG8_BAR;
    } else {
        PG8_STAGE(PG8_SB(0, 0), cB, voffB); PG8_STAGE(PG8_SA(0, 0), cA, voffA); PG8_STAGE(PG8_SB(0, 1), cB + hstepB, voffB); PG8_STAGE(PG8_SA(0, 1), cA + hstepA, voffA);
        if (wr == 1) PG8_BAR;
        PG8_WAIT_V(4); PG8_BAR;
        PG8_STAGE(PG8_SB(1, 0), cB + kstep, voffB); PG8_STAGE(PG8_SA(1, 0), cA + kstep, voffA); PG8_STAGE(PG8_SB(1, 1), cB + hstepB + kstep, voffB);
        PG8_WAIT_V(6); PG8_BAR;
    }
    for (;;) {
        const bool has_next = S.next(ui + 1, nxt);
        const char* nA = has_next ? (const char*)g.A + (size_t)nxt.pm * tstepA : cA; const char* nB = has_next ? (const char*)g.Bt + (size_t)nxt.pn * tstepB : cB;
        for (int t = 0; t < nt; t += 2) {
            const bool last = (t == nt - 2);
            const char* a1 = cA + (size_t)(t + 1) * kstep;
            const char* a2 = last ? nA : cA + (size_t)(t + 2) * kstep; const char* b2 = last ? nB : cB + (size_t)(t + 2) * kstep;
            const char* a3 = a2 + kstep; const char* b3 = b2 + kstep;
            if (last) E.pre(pre, cur, wr, fr);
            if constexpr (SP2) {
            PG8_LDB(B0, 0, 0); PG8_LDB(B1, 0, 1); PG8_SCHED; PG8_LDA(At, 0, 0); PG8_STAGE(PG8_SA(1, 1), a1 + hstepA, voffA);
            if (HASPRE && last) { PG8_WAIT_V(16); } else { PG8_WAIT_V(8); }
            PG8_WAIT_L(0); PG8_BAR; PG8_MMA(0, 0, At, B0); PG8_MMA(0, 1, At, B1); PG8_BAR; PG8_SCHED;
            PG8_LDA(At, 0, 1); PG8_STAGE(PG8_SB(0, 0), b2, voffB); PG8_STAGE(PG8_SB(0, 1), b2 + hstepB, voffB); PG8_STAGE(PG8_SA(0, 0), a2, voffA);
            if (HASPRE && last) { PG8_WAIT_V(16); } else { PG8_WAIT_V(8); }
            PG8_WAIT_L(0); PG8_BAR; PG8_MMA(1, 0, At, B0); PG8_MMA(1, 1, At, B1); PG8_BAR; PG8_SCHED;
            PG8_LDB(B0, 1, 0); PG8_LDB(B1, 1, 1); PG8_SCHED; PG8_LDA(At, 1, 0); PG8_STAGE(PG8_SA(0, 1), a2 + hstepA, voffA);
            PG8_WAIT_V(8); PG8_WAIT_L(0); PG8_BAR; PG8_MMA(0, 0, At, B0); PG8_MMA(0, 1, At, B1); PG8_BAR; PG8_SCHED;
            PG8_LDA(At, 1, 1); PG8_STAGE(PG8_SB(1, 0), b3, voffB); PG8_STAGE(PG8_SB(1, 1), b3 + hstepB, voffB); PG8_STAGE(PG8_SA(1, 0), a3, voffA);
            PG8_WAIT_V(8); PG8_WAIT_L(0); PG8_BAR; PG8_MMA(1, 0, At, B0); PG8_MMA(1, 1, At, B1); PG8_BAR; PG8_SCHED;
            } else {
            PG8_LDB(B0, 0, 0); PG8_SCHED; PG8_LDA(At, 0, 0); PG8_STAGE(PG8_SA(1, 1), a1 + hstepA, voffA);
            PG8_WAIT_L(8); PG8_BAR; PG8_WAIT_L(0); PG8_MMA(0, 0, At, B0); PG8_BAR; PG8_SCHED;
            PG8_LDB(B1, 0, 1); PG8_STAGE(PG8_SB(0, 0), b2, voffB);
            PG8_BAR; PG8_WAIT_L(0); PG8_MMA(0, 1, At, B1); PG8_BAR;
            PG8_LDA(At, 0, 1); PG8_STAGE(PG8_SA(0, 0), a2, voffA);
            PG8_BAR; PG8_WAIT_L(0); PG8_MMA(1, 0, At, B0); PG8_BAR; PG8_SCHED;
            PG8_STAGE(PG8_SB(0, 1), b2 + hstepB, voffB);
            PG8_WAIT_V(6); PG8_BAR; PG8_MMA(1, 1, At, B1); PG8_BAR;
            PG8_LDB(B0, 1, 0); PG8_SCHED; PG8_LDA(At, 1, 0); PG8_STAGE(PG8_SA(0, 1), a2 + hstepA, voffA);
            PG8_WAIT_L(8); PG8_BAR; PG8_WAIT_L(0); PG8_MMA(0, 0, At, B0); PG8_BAR; PG8_SCHED;
            PG8_LDB(B1, 1, 1); PG8_STAGE(PG8_SB(1, 0), b3, voffB);
            PG8_BAR; PG8_WAIT_L(0); PG8_MMA(0, 1, At, B1); PG8_BAR;
            PG8_LDA(At, 1, 1); PG8_STAGE(PG8_SA(1, 0), a3, voffA);
            PG8_BAR; PG8_WAIT_L(0); PG8_MMA(1, 0, At, B0); PG8_BAR; PG8_SCHED;
            PG8_STAGE(PG8_SB(1, 1), b3 + hstepB, voffB);
            PG8_WAIT_V(6); PG8_BAR; PG8_MMA(1, 1, At, B1); PG8_BAR;
            }
        }
        if constexpr (ALIGN_EPI) { if (wr == 0) PG8_BAR; }
        E(acc, cur, wr, wc, fr, fq, pre);
        if (!has_next) break;
#pragma unroll
        for (int a = 0; a < 2; ++a)
#pragma unroll
            for (int b = 0; b < 2; ++b)
#pragma unroll
                for (int m = 0; m < 4; ++m)
#pragma unroll
                    for (int n = 0; n < 2; ++n) acc[a][b][m][n] = (f32x4){0.f, 0.f, 0.f, 0.f};
        cur = nxt; cA = nA; cB = nB; ++ui;
        if constexpr (ALIGN_EPI) { if (wr == 1) PG8_BAR; }
    }
    PG8_WAIT_V(0);
    if constexpr (!ALIGN_EPI) { if (wr == 0) PG8_BAR; }
    PG8_BAR;
#undef PG8_SA
#undef PG8_SB
#undef PG8_STAGE
#undef PG8_LDA
#undef PG8_LDB
#undef PG8_MMA
#undef PG8_WAIT_V
#undef PG8_WAIT_L
#undef PG8_BAR
#undef PG8_SCHED
}
}
using pg8::Unit;
typedef const f32x4 (&AccRef)[2][2][4][2];


struct EpiIn {
    static constexpr bool PERM = true;
    struct Pre { float rs[8]; };
    __device__ __forceinline__ void pre(Pre& p, const Unit& u, int wr, int fr) const {
#pragma unroll
        for (int i = 0; i < 8; ++i) p.rs[i] = ss0[u.pm * 256 + wr * 64 + fr + (i >> 2) * 128 + (i & 3) * 16];
    }
    const float* ss0; bf16_t* ucat; bf16_t* q; bf16_t* k; bf16_t* v; const float* qg; const float* kg;
    __device__ __forceinline__ void operator()(AccRef acc, const Unit& u, int wr, int wc, int fr, int fq, const Pre& pre) const {
        const int row0 = u.pm * 256 + wr * 64 + fr;
        if (u.pn < 2) {
#pragma unroll
            for (int ai = 0; ai < 2; ++ai)
#pragma unroll
                for (int m = 0; m < 4; ++m) {
                    const int row = row0 + ai * 128 + m * 16; const float rs = rsqrtf(pre.rs[ai * 4 + m] * (1.0f / 1024.0f) + EPS);
                    const int b = row >> 12, l = row & 4095, sc = l >> 5, s = l & 31;
#pragma unroll
                    for (int bj = 0; bj < 2; ++bj) {
                        const int c = u.pn * 256 + bj * 128 + wc * 32 + 8 * fq, g = c >> 4, hi = c & 15;
                        bf16_t* dst = ucat + (size_t)(g * 1024 + b * 128 + sc) * 640 + s * 16 + hi;
                        *(u32x4*)dst = pk8(acc[ai][bj][m][0] * rs, acc[ai][bj][m][1] * rs);
                    }
                }
        } else {
            const int t = (u.pn - 2) >> 1, head = ((u.pn - 2) & 1) * 4 + wc;
            bf16_t* base = q + (size_t)t * (size_t)(NBATCH * 8 * SEQ * 64);
            const float* gp = t == 0 ? qg : kg;
#pragma unroll
            for (int ai = 0; ai < 2; ++ai)
#pragma unroll
                for (int m = 0; m < 4; ++m) {
                    const int row = row0 + ai * 128 + m * 16; const float rs = rsqrtf(pre.rs[ai * 4 + m] * (1.0f / 1024.0f) + EPS);
                    const int b = row >> 12, l = row & 4095;
                    float sc2 = rs;
                    if (t < 2) {
                        float ssq = 0.f;
#pragma unroll
                        for (int bj = 0; bj < 2; ++bj)
#pragma unroll
                            for (int n = 0; n < 2; ++n) { const f32x4 x = acc[ai][bj][m][n]; ssq += (x[0] * x[0] + x[1] * x[1]) + (x[2] * x[2] + x[3] * x[3]); }
                        ssq += __shfl_xor(ssq, 16); ssq += __shfl_xor(ssq, 32);
                        sc2 = rs * rsqrtf(ssq * rs * rs * (1.0f / 64.0f) + EPS) * (t == 0 ? 0.125f * 1.44269504089f : 1.0f);
                    }
                    bf16_t* dst = base + ((size_t)(b * 8 + head) * 4096 + l) * 64;
#pragma unroll
                    for (int bj = 0; bj < 2; ++bj) {
                        f32x4 v0 = acc[ai][bj][m][0] * sc2, v1 = acc[ai][bj][m][1] * sc2;
                        if (t < 2) { v0 = v0 * *(const f32x4*)(gp + 32 * bj + 8 * fq); v1 = v1 * *(const f32x4*)(gp + 32 * bj + 8 * fq + 4); }
                        *(u32x4*)(dst + 32 * bj + 8 * fq) = pk8(v0, v1);
                    }
                    asm volatile("" ::: "memory");
                }
        }
    }
};
struct EpiS {
    static constexpr bool PERM = true;
    struct Pre {}; __device__ __forceinline__ void pre(Pre&, const Unit&, int, int) const {}
    float* sloc;
    __device__ __forceinline__ void operator()(AccRef acc, const Unit& u, int wr, int wc, int fr, int fq, const Pre& pre) const {
        const int row0 = u.pm * 256 + wr * 64 + fr;
#pragma unroll
        for (int ai = 0; ai < 2; ++ai)
#pragma unroll
            for (int m = 0; m < 4; ++m) { float* rp = sloc + (size_t)(row0 + ai * 128 + m * 16) * 128 + wc * 32 + 8 * fq;
                *(f32x4*)rp = acc[ai][0][m][0]; *(f32x4*)(rp + 4) = acc[ai][0][m][1]; }
    }
};
struct EpiY {
    static constexpr bool PERM = true;
    struct Pre {}; __device__ __forceinline__ void pre(Pre&, const Unit&, int, int) const {}
    const bf16_t* ucat; const float* dvec; bf16_t* ybuf;
    __device__ __forceinline__ void operator()(AccRef acc, const Unit& u, int wr, int wc, int fr, int fq, const Pre& pre) const {
        const int g = u.pm >> 2;
#pragma unroll
        for (int ai = 0; ai < 2; ++ai)
#pragma unroll
            for (int m = 0; m < 4; ++m) {
                const int R = u.pm * 256 + ai * 128 + wr * 64 + m * 16 + fr, rem = R & 1023, b = rem >> 7, sc = rem & 127;
#pragma unroll
                for (int bj = 0; bj < 2; ++bj) {
                    const int nc = (u.pn & 1) * 256 + bj * 128 + wc * 32 + 8 * fq, t = nc >> 4, ho = nc & 15, ch = g * 16 + ho, l = sc * 32 + t;
                    const u32x4 uw = *(const u32x4*)(ucat + (size_t)R * 640 + nc);
                    f32x4 y0 = acc[ai][bj][m][0] + *(const f32x4*)(dvec + ch) * unpk8lo(uw), y1 = acc[ai][bj][m][1] + *(const f32x4*)(dvec + ch + 4) * unpk8hi(uw);
#pragma unroll
                    for (int j = 0; j < 4; ++j) { const float v = y0[j]; const float a = 1.5957691216f * (v + 0.044715f * v * v * v); y0[j] = v * __builtin_amdgcn_rcpf(1.0f + __expf(-a));
                                                  const float w = y1[j]; const float c = 1.5957691216f * (w + 0.044715f * w * w * w); y1[j] = w * __builtin_amdgcn_rcpf(1.0f + __expf(-c)); }
                    *(u32x4*)(ybuf + (size_t)(b * 4096 + l) * 512 + ch) = pk8(y0, y1);
                }
            }
    }
};
struct EpiGlu {
    static constexpr bool PERM = true;
    struct Pre {}; __device__ __forceinline__ void pre(Pre&, const Unit&, int, int) const {}
    const bf16_t* ybuf; bf16_t* mixed;
    __device__ __forceinline__ void operator()(AccRef acc, const Unit& u, int wr, int wc, int fr, int fq, const Pre& pre) const {
        const int row0 = u.pm * 256 + wr * 64 + fr, col0 = u.pn * 256 + wc * 32 + 8 * fq;
#pragma unroll
        for (int ai = 0; ai < 2; ++ai)
#pragma unroll
            for (int m = 0; m < 4; ++m) { const int row = row0 + ai * 128 + m * 16;
#pragma unroll
                for (int bj = 0; bj < 2; ++bj) { const int c = col0 + bj * 128;
                    const u32x4 yw = *(const u32x4*)(ybuf + (size_t)row * 512 + c); const f32x4 ya = unpk8lo(yw), yb = unpk8hi(yw); f32x4 o0, o1;
#pragma unroll
                    for (int j = 0; j < 4; ++j) { o0[j] = ya[j] * sigmoidf_(acc[ai][bj][m][0][j]); o1[j] = yb[j] * sigmoidf_(acc[ai][bj][m][1][j]); }
                    *(u32x4*)(mixed + (size_t)row * 1024 + c) = pk8(o0, o1); } }
    }
};
template <int MODE> struct EpiRes {
    static constexpr bool PERM = true;
    struct Pre {}; __device__ __forceinline__ void pre(Pre&, const Unit&, int, int) const {}
    const void* base; bf16_t* hb; float* ss; const float* cscale;
    __device__ __forceinline__ void operator()(AccRef acc, const Unit& u, int wr, int wc, int fr, int fq, const Pre& pre) const {
        const int pmr = MODE == 2 ? (u.pm & 127) : u.pm;
        const int row0 = pmr * 256 + wr * 64 + fr, col0 = u.pn * 256 + wc * 32 + 8 * fq;
#pragma unroll
        for (int ai = 0; ai < 2; ++ai) {
            u32x4 bw[4][2];
            if (MODE != 0) {
#pragma unroll
                for (int m = 0; m < 4; ++m)
#pragma unroll
                    for (int bj = 0; bj < 2; ++bj) bw[m][bj] = *(const u32x4*)((const bf16_t*)base + (size_t)(row0 + ai * 128 + m * 16) * 1024 + col0 + bj * 128);
            }
#pragma unroll
            for (int m = 0; m < 4; ++m) { const int row = row0 + ai * 128 + m * 16; float part = 0.f;
#pragma unroll
                for (int bj = 0; bj < 2; ++bj) { const size_t o = (size_t)row * 1024 + col0 + bj * 128;
                    f32x4 b0, b1;
                    if (MODE == 0) { b0 = *(const f32x4*)((const float*)base + o); b1 = *(const f32x4*)((const float*)base + o + 4); }
                    else { b0 = unpk8lo(bw[m][bj]); b1 = unpk8hi(bw[m][bj]); }
                    const f32x4 h0 = b0 + acc[ai][bj][m][0], h1 = b1 + acc[ai][bj][m][1];
                    *(u32x4*)(hb + o) = pk8(h0, h1);
                    part += ((h0[0] * h0[0] + h0[1] * h0[1]) + (h0[2] * h0[2] + h0[3] * h0[3])) + ((h1[0] * h1[0] + h1[1] * h1[1]) + (h1[2] * h1[2] + h1[3] * h1[3])); }
                part += __shfl_xor(part, 16); part += __shfl_xor(part, 32);
                if (fq == 0) atomicAdd(ss + row, part); }
            asm volatile("" ::: "memory"); }
    }
};
struct EpiUp {
    static constexpr bool PERM = true;
    struct Pre { float rs[8]; };
    __device__ __forceinline__ void pre(Pre& p, const Unit& u, int wr, int fr) const {
#pragma unroll
        for (int i = 0; i < 8; ++i) p.rs[i] = ss[u.pm * 256 + wr * 64 + fr + (i >> 2) * 128 + (i & 3) * 16];
    }
    const float* ss; bf16_t* hid;
    __device__ __forceinline__ void operator()(AccRef acc, const Unit& u, int wr, int wc, int fr, int fq, const Pre& pre) const {
        const int row0 = u.pm * 256 + wr * 64 + fr, col0 = u.pn * 256 + wc * 32 + 8 * fq;
#pragma unroll
        for (int ai = 0; ai < 2; ++ai)
#pragma unroll
            for (int m = 0; m < 4; ++m) { const int row = row0 + ai * 128 + m * 16; const float rs = rsqrtf(pre.rs[ai * 4 + m] * (1.0f / 1024.0f) + EPS);
#pragma unroll
                for (int bj = 0; bj < 2; ++bj) { f32x4 v0 = acc[ai][bj][m][0] * rs, v1 = acc[ai][bj][m][1] * rs;
#pragma unroll
                    for (int j = 0; j < 4; ++j) { const float r0 = fmaxf(v0[j], 0.f), r1 = fmaxf(v1[j], 0.f); v0[j] = r0 * r0; v1[j] = r1 * r1; }
                    u32x4 w; w.x = pk2(v0[0], v0[1]); w.y = pk2(v0[2], v0[3]); w.z = pk2(v1[0], v1[1]); w.w = pk2(v1[2], v1[3]);
                    __builtin_nontemporal_store(w, (u32x4*)(hid + (size_t)row * 4096 + col0 + bj * 128)); } }
    }
};
struct EpiE {
    static constexpr bool PERM = true;
    struct Pre {}; __device__ __forceinline__ void pre(Pre&, const Unit&, int, int) const {}
    bf16_t* eb;
    __device__ __forceinline__ void operator()(AccRef acc, const Unit& u, int wr, int wc, int fr, int fq, const Pre& pre) const {
        const int row0 = u.pm * 256 + wr * 64 + fr, col0 = u.pn * 256 + wc * 32 + 8 * fq;
#pragma unroll
        for (int ai = 0; ai < 2; ++ai)
#pragma unroll
            for (int m = 0; m < 4; ++m) { const int row = row0 + ai * 128 + m * 16;
#pragma unroll
                for (int bj = 0; bj < 2; ++bj) *(u32x4*)(eb + (size_t)row * 1024 + col0 + bj * 128) = pk8(acc[ai][bj][m][0], acc[ai][bj][m][1]); }
    }
};
template <bool FINAL> struct EpiGate {
    static constexpr bool PERM = true;
    struct Pre { float rs[8]; };
    __device__ __forceinline__ void pre(Pre& p, const Unit& u, int wr, int fr) const {
#pragma unroll
        for (int i = 0; i < 8; ++i) p.rs[i] = ss_in[u.pm * 256 + wr * 64 + fr + (i >> 2) * 128 + (i & 3) * 16];
    }
    const bf16_t* base; float* out; bf16_t* hb2; const bf16_t* eb; const float* ss_in; float* ss_out;
    __device__ __forceinline__ void operator()(AccRef acc, const Unit& u, int wr, int wc, int fr, int fq, const Pre& pre) const {
        const int row0 = u.pm * 256 + wr * 64 + fr, col0 = u.pn * 256 + wc * 32 + 8 * fq;
#pragma unroll
        for (int ai = 0; ai < 2; ++ai) {
            u32x4 bw[4][2], ew[4][2];
#pragma unroll
            for (int m = 0; m < 4; ++m)
#pragma unroll
                for (int bj = 0; bj < 2; ++bj) { const size_t o = (size_t)(row0 + ai * 128 + m * 16) * 1024 + col0 + bj * 128; bw[m][bj] = *(const u32x4*)(base + o); ew[m][bj] = *(const u32x4*)(eb + o); }
#pragma unroll
            for (int m = 0; m < 4; ++m) { const int row = row0 + ai * 128 + m * 16; const float rs = rsqrtf(pre.rs[ai * 4 + m] * (1.0f / 1024.0f) + EPS); float part = 0.f;
#pragma unroll
                for (int bj = 0; bj < 2; ++bj) { const size_t o = (size_t)row * 1024 + col0 + bj * 128;
                    const f32x4 e0 = unpk8lo(ew[m][bj]), e1 = unpk8hi(ew[m][bj]); f32x4 h0 = unpk8lo(bw[m][bj]), h1 = unpk8hi(bw[m][bj]);
#pragma unroll
                    for (int j = 0; j < 4; ++j) { h0[j] += e0[j] * sigmoidf_(acc[ai][bj][m][0][j] * rs); h1[j] += e1[j] * sigmoidf_(acc[ai][bj][m][1][j] * rs); }
                    if (FINAL) { *(f32x4*)(out + o) = h0; *(f32x4*)(out + o + 4) = h1; } else *(u32x4*)(hb2 + o) = pk8(h0, h1);
                    part += ((h0[0] * h0[0] + h0[1] * h0[1]) + (h0[2] * h0[2] + h0[3] * h0[3])) + ((h1[0] * h1[0] + h1[1] * h1[1]) + (h1[2] * h1[2] + h1[3] * h1[3])); }
                if (!FINAL) { part += __shfl_xor(part, 16); part += __shfl_xor(part, 32); if (fq == 0) atomicAdd(ss_out + row, part); } }
            asm volatile("" ::: "memory"); }
    }
};

struct Args {
    const float* in[25]; float* out; unsigned char* ws; int ph_lo, ph_hi;
};
enum { I_X = 0, I_P, I_LN_EVEN, I_WIN, I_LRE, I_LIM, I_LOGDT, I_BRE, I_BIM, I_CRE, I_CIM, I_D, I_WGLU, I_QG, I_KG, I_WOUT, I_LN_ODD, I_POOLW, I_POOLS, I_LN_MLP, I_WUP, I_WDOWN, I_LN_PLE, I_WGATE, I_WPLE };

__device__ __forceinline__ int rowmap_in(int n) {
    if (n < 512) return n;
    const int tile = n >> 8, lc = n & 255, hd = lc >> 6, dd = lc & 63;
    return (tile << 8) + ((dd >> 5) << 7) + (hd << 5) + (dd & 31);
}
__device__ __forceinline__ void xpose_item(const float* W, int K, int N, bf16_t* WT, const float* gain, int mode, LAS float* scr, int item, int lane, const float* ngain = nullptr) {
    const int nblk = N / 32, kb = item / nblk, nb = item % nblk, k0 = 64 * kb, n0 = 32 * nb;
    float wv[32];
#pragma unroll
    for (int i = 0; i < 32; ++i) { const int kk = 2 * i + (lane >> 5); wv[i] = W[(size_t)(k0 + kk) * N + n0 + (lane & 31)]; }
#pragma unroll
    for (int i = 0; i < 32; ++i) { const int kk = 2 * i + (lane >> 5); const float gvv = gain ? gain[k0 + kk] : 1.0f; scr[kk * 33 + (lane & 31)] = wv[i] * gvv; }
    asm volatile("s_waitcnt lgkmcnt(0)" ::: "memory");
    const int c = lane & 7;
#pragma unroll
    for (int j = 0; j < 4; ++j) { const int n = (lane >> 3) + 8 * j; const LAS float* s = scr + (8 * c) * 33 + n;
        const float ng = ngain ? ngain[n0 + n] : 1.0f;
        u32x4 o; o.x = pk2(s[0 * 33] * ng, s[1 * 33] * ng); o.y = pk2(s[2 * 33] * ng, s[3 * 33] * ng); o.z = pk2(s[4 * 33] * ng, s[5 * 33] * ng); o.w = pk2(s[6 * 33] * ng, s[7 * 33] * ng);
        int nr = n0 + n; if (mode == 1) nr = rowmap_in(nr);
        *(u32x4*)(WT + (size_t)nr * K + k0 + 8 * c) = o; }
    asm volatile("s_waitcnt lgkmcnt(0)" ::: "memory");
}
struct C2 { float r, i; };
__device__ __forceinline__ C2 cmul(C2 a, C2 b) { return C2{a.r * b.r - a.i * b.i, a.r * b.i + a.i * b.r}; }
__device__ __forceinline__ C2 s5_apow(float lr, float li, float dt, float tau) {
    const float mag = __expf(lr * dt * tau);
    float sn, cs; sincosf(li * dt * tau, &sn, &cs);
    return C2{mag * cs, mag * sn};
}
__device__ __forceinline__ C2 s5_zoh(float lr, float li, float dt) {
    const float x = lr * dt, y = li * dt;
    float sn, cs; sincosf(y, &sn, &cs);
    const float sh = sinf(0.5f * y), em1 = expm1f(x);
    const float nr = em1 * cs - 2.0f * sh * sh, ni = (em1 + 1.0f) * sn;
    const float den = lr * lr + li * li;
    return C2{(nr * lr + ni * li) / den, (ni * lr - nr * li) / den};
}

__device__ __forceinline__ void phase_prep(const Args& a, LAS unsigned char* lds, int wg, int G) {
    const int tid = threadIdx.x, lane = tid & 63, wid = tid >> 6;
    unsigned char* ws = a.ws;
    const int gw = wg * 8 + wid, NGW = G * 8;
    const size_t gt = (size_t)wg * 512 + tid, NGT = (size_t)G * 512;
    {
        LAS float* scr = (LAS float*)(lds + wid * 8448);
        constexpr int I0 = 1024, I1 = 128, I2 = 512, I3 = 2048, I4 = 2048, I5 = 512, I6 = 128, I7 = 32;
        constexpr int NIT = I0 + I1 + I2 + 2 * I3 + 2 * I4 + 2 * I5 + 2 * I6 + 4 * I7;
        for (int it = gw; it < NIT; it += NGW) {
            int r = it;
            if (r < I0) { xpose_item(a.in[I_WIN], 1024, 2048, (bf16_t*)(ws + WS_WIN), a.in[I_LN_EVEN], 1, scr, r, lane); continue; } r -= I0;
            if (r < I1) { xpose_item(a.in[I_WGLU], 512, 512, (bf16_t*)(ws + WS_WGLU), nullptr, 0, scr, r, lane); continue; } r -= I1;
            if (r < I2) { xpose_item(a.in[I_WOUT], 1024, 1024, (bf16_t*)(ws + WS_WOUT), nullptr, 0, scr, r, lane); continue; } r -= I2;
            if (r < 2 * I3) { const int i = r / I3; xpose_item(a.in[I_WUP] + (size_t)i * 1024 * 4096, 1024, 4096, (bf16_t*)(ws + WS_WUP) + (size_t)i * 4096 * 1024, a.in[I_LN_MLP] + i * 1024, 0, scr, r % I3, lane); continue; } r -= 2 * I3;
            if (r < 2 * I4) { const int i = r / I4; xpose_item(a.in[I_WDOWN] + (size_t)i * 4096 * 1024, 4096, 1024, (bf16_t*)(ws + WS_WDOWN) + (size_t)i * 1024 * 4096, nullptr, 0, scr, r % I4, lane); continue; } r -= 2 * I4;
            if (r < 2 * I5) { const int i = r / I5; xpose_item(a.in[I_WGATE] + (size_t)i * 1024 * 1024, 1024, 1024, (bf16_t*)(ws + WS_WGATE) + (size_t)i * 1024 * 1024, a.in[I_LN_PLE] + i * 1024, 0, scr, r % I5, lane); continue; } r -= 2 * I5;
            if (r < 2 * I6) { const int i = r / I6; xpose_item(a.in[I_WPLE] + (size_t)i * 256 * 1024, 256, 1024, (bf16_t*)(ws + WS_WPLE) + (size_t)i * 1024 * 256, nullptr, 0, scr, r % I6, lane); continue; } r -= 2 * I6;
            { const int i = r / I7; xpose_item(a.in[I_POOLW] + (size_t)i * 256 * 256, 256, 256, (bf16_t*)(ws + WS_WPOOL) + (size_t)i * 256 * 256, a.in[I_LN_ODD] + i * 256, 0, scr, r % I7, lane, a.in[I_POOLS] + i * 256); }
        }
    }
    {
        const float* x = a.in[I_X]; bf16_t* xb = (bf16_t*)a.out + (size_t)MTOK * 1024; float* ss0 = (float*)(ws + WS_SS);
        for (int m = 2 * gw; m < MTOK; m += 2 * NGW) {
            const f32x4* xr = (const f32x4*)(x + (size_t)m * 1024) + lane; u32x2* o = (u32x2*)(xb + (size_t)m * 1024) + lane;
            f32x4 v[8];
#pragma unroll
            for (int j = 0; j < 8; ++j) v[j] = xr[64 * j];
            float s0 = 0.f, s1 = 0.f;
#pragma unroll
            for (int j = 0; j < 4; ++j) { s0 += (v[j][0] * v[j][0] + v[j][1] * v[j][1]) + (v[j][2] * v[j][2] + v[j][3] * v[j][3]); s1 += (v[4 + j][0] * v[4 + j][0] + v[4 + j][1] * v[4 + j][1]) + (v[4 + j][2] * v[4 + j][2] + v[4 + j][3] * v[4 + j][3]); }
#pragma unroll
            for (int j = 0; j < 8; ++j) o[64 * j] = pk4(v[j]);
#pragma unroll
            for (int off = 1; off < 64; off <<= 1) { s0 += __shfl_xor(s0, off); s1 += __shfl_xor(s1, off); }
            if (lane == 0) { ss0[m] = s0; ss0[m + 1] = s1; }
        }
    }
    {
        const f32x4* p4 = (const f32x4*)a.in[I_P]; u32x2* pb = (u32x2*)(ws + WS_PB);
        for (size_t i = gt; i < (size_t)2 * MTOK * 256 / 4; i += 4 * NGT) {
            f32x4 v[4];
#pragma unroll
            for (int j = 0; j < 4; ++j) v[j] = (i + j * NGT < (size_t)2 * MTOK * 256 / 4) ? p4[i + j * NGT] : (f32x4){0.f, 0.f, 0.f, 0.f};
#pragma unroll
            for (int j = 0; j < 4; ++j) if (i + j * NGT < (size_t)2 * MTOK * 256 / 4) pb[i + j * NGT] = pk4(v[j]);
        }
        float* ss = (float*)(ws + WS_SS) + MTOK;
        for (size_t i = gt; i < (size_t)5 * MTOK; i += NGT) ss[i] = 0.f;
    }
    const float* lre = a.in[I_LRE]; const float* lim = a.in[I_LIM]; const float* ldt = a.in[I_LOGDT];
    const float* bre = a.in[I_BRE]; const float* bim = a.in[I_BIM]; const float* cre = a.in[I_CRE]; const float* cim = a.in[I_CIM];
    bf16_t* wst = (bf16_t*)(ws + WS_WST); bf16_t* wtz = (bf16_t*)(ws + WS_WTZ); float* at = (float*)(ws + WS_AT);
    for (size_t i = gt; i < 2048; i += NGT) { const int g = (int)i >> 6; const float dt = __expf(ldt[g]); const C2 ap = s5_apow(lre[i], lim[i], dt, 32.0f); at[2 * i] = ap.r; at[2 * i + 1] = ap.i; }
    for (size_t i = gt; i < (size_t)32 * 64 * 32; i += NGT) {
        const int s = (int)i & 31, gp = (int)(i >> 5), g = gp >> 6, p = gp & 63;
        const float dt = __expf(ldt[g]), lr = lre[gp], li = lim[gp];
        const C2 co = cmul(s5_apow(lr, li, dt, (float)(31 - s)), s5_zoh(lr, li, dt));
        const float* br = bre + (size_t)gp * 16; const float* bi = bim + (size_t)gp * 16;
        float vr[16], vi[16];
#pragma unroll
        for (int h = 0; h < 16; ++h) { const C2 v = cmul(co, C2{br[h], bi[h]}); vr[h] = v.r; vi[h] = v.i; }
        bf16_t* d0 = wst + (size_t)(g * 256 + 2 * p) * 512 + s * 16; bf16_t* d1 = d0 + 512;
        u32x4 w;
        w.x = pk2(vr[0], vr[1]); w.y = pk2(vr[2], vr[3]); w.z = pk2(vr[4], vr[5]); w.w = pk2(vr[6], vr[7]); *(u32x4*)d0 = w;
        w.x = pk2(vr[8], vr[9]); w.y = pk2(vr[10], vr[11]); w.z = pk2(vr[12], vr[13]); w.w = pk2(vr[14], vr[15]); *(u32x4*)(d0 + 8) = w;
        w.x = pk2(vi[0], vi[1]); w.y = pk2(vi[2], vi[3]); w.z = pk2(vi[4], vi[5]); w.w = pk2(vi[6], vi[7]); *(u32x4*)d1 = w;
        w.x = pk2(vi[8], vi[9]); w.y = pk2(vi[10], vi[11]); w.z = pk2(vi[12], vi[13]); w.w = pk2(vi[14], vi[15]); *(u32x4*)(d1 + 8) = w;
    }
    for (size_t i = gt; i < (size_t)32 * 128 * 64; i += NGT) {
        const int ch = (int)i & 63, rr = (int)(i >> 6), g = rr >> 7, n = 128 + (rr & 127);
        *(u32x4*)(wst + (size_t)(g * 256 + n) * 512 + ch * 8) = (u32x4){0u, 0u, 0u, 0u};
    }
    for (size_t i = gt; i < (size_t)32 * 512 * 64; i += NGT) {
        const int p = (int)i & 63, gn = (int)(i >> 6), g = gn >> 9, n = gn & 511, t = n >> 4, ho = n & 15, gp = g * 64 + p;
        const float dt = __expf(ldt[g]);
        const C2 cc = cmul(C2{cre[(size_t)(g * 16 + ho) * 64 + p], cim[(size_t)(g * 16 + ho) * 64 + p]}, s5_apow(lre[gp], lim[gp], dt, (float)(t + 1)));
        *(unsigned*)(wtz + (size_t)gn * 640 + 512 + 2 * p) = pk2(cc.r, -cc.i);
    }
    for (size_t i = gt; i < (size_t)32 * 512 * 32; i += NGT) {
        const int s = (int)i & 31, gn = (int)(i >> 5), t = (gn & 511) >> 4;
        if (s > t) { u32x4* d = (u32x4*)(wtz + (size_t)gn * 640 + s * 16); d[0] = (u32x4){0u, 0u, 0u, 0u}; d[1] = (u32x4){0u, 0u, 0u, 0u}; }
    }
    {
        LAS float* EA = (LAS float*)(lds + 69632);
        LAS float* Er = EA + 128; LAS float* Ei = Er + 1024;
        for (int it = wg; it < 1024; it += G) {
            const int g = it >> 5, tau = it & 31;
            __syncthreads();
            if (tid < 64) { const int gp = g * 64 + tid; const float dt = __expf(ldt[g]); const float lr = lre[gp], li = lim[gp];
                const C2 e = cmul(s5_apow(lr, li, dt, (float)tau), s5_zoh(lr, li, dt)); EA[2 * tid] = e.r; EA[2 * tid + 1] = e.i; }
            __syncthreads();
            for (int e = tid; e < 1024; e += 512) { const int p = e >> 4; const C2 v = cmul(C2{EA[2 * p], EA[2 * p + 1]}, C2{bre[(size_t)g * 1024 + e], bim[(size_t)g * 1024 + e]}); Er[e] = v.r; Ei[e] = v.i; }
            __syncthreads();
            if (tid < 256) {
                const int ho = tid >> 4, hi = tid & 15; const float* cr = cre + (size_t)(g * 16 + ho) * 64; const float* ci = cim + (size_t)(g * 16 + ho) * 64;
                float acc = 0.f;
#pragma unroll 8
                for (int p = 0; p < 64; ++p) acc += cr[p] * Er[p * 16 + hi] - ci[p] * Ei[p * 16 + hi];
                const bf16_t kv = (bf16_t)(pk2(acc, acc) & 0xffffu);
                for (int t = tau; t < 32; ++t) wtz[(size_t)(g * 512 + t * 16 + ho) * 640 + (t - tau) * 16 + hi] = kv;
            }
        }
        __syncthreads();
    }
}

__device__ __forceinline__ int attn_item(int it, int G, int wg) {
    if (G == 256) { if (it < 7) return it * 256 + wg; if (wg >= 128 && it < 9) return 1792 + (it - 7) * 128 + (wg - 128); return -1; }
    const int item = it * G + wg; return item < 2048 ? item : -1;
}
__device__ __forceinline__ void phase_attn(const Args& a, LAS unsigned char* lds, int wg, int G) {
    const int tid = threadIdx.x, lane = tid & 63, wid = __builtin_amdgcn_readfirstlane(tid >> 6), fr = lane & 15, fq = lane >> 4, hsel = wid >> 2;
    const bf16_t* qb_ = (const bf16_t*)(a.ws + WS_Q); const bf16_t* kb_ = (const bf16_t*)(a.ws + WS_K); const bf16_t* vb_ = (const bf16_t*)(a.ws + WS_V);
    bf16_t* mixed = (bf16_t*)(a.ws + WS_MIXED);
    LAS int* flags = (LAS int*)(lds + 73728);
    f16x8 mka, mkb, ones;
#pragma unroll
    for (int j = 0; j < 8; ++j) { const int kl = 16 * (j >> 2) + 4 * fq + (j & 3); mka[j] = (kl > fr) ? (_Float16)1.0f : (_Float16)0.0f; mkb[j] = (kl > 16 + fr) ? (_Float16)1.0f : (_Float16)0.0f; ones[j] = (_Float16)1.0f; }
    const int r_st = tid >> 3, c8_st = (tid & 7) * 8;
    int item = attn_item(0, G, wg);
    bf16x8 qf[2]; u32x4 kreg0, vreg0, kreg1, vreg1;
    if (item >= 0) { const int qblk = 63 - (item >> 5), bhp = item & 31, bh0 = (bhp >> 2) * 8 + (bhp & 3) * 2; const size_t h0 = (size_t)bh0 * 4096 * 64, hm = h0 + (size_t)hsel * 4096 * 64;
        const int qrow = qblk * 64 + (wid & 3) * 16 + fr, kt = qblk;
        qf[0] = *(const bf16x8*)(qb_ + hm + (size_t)qrow * 64 + fq * 8); qf[1] = *(const bf16x8*)(qb_ + hm + (size_t)qrow * 64 + 32 + fq * 8);
        kreg0 = *(const u32x4*)(kb_ + h0 + (size_t)(kt * 64 + r_st) * 64 + c8_st); vreg0 = *(const u32x4*)(vb_ + h0 + (size_t)(kt * 64 + r_st) * 64 + c8_st);
        kreg1 = *(const u32x4*)(kb_ + h0 + (size_t)(4096 + kt * 64 + r_st) * 64 + c8_st); vreg1 = *(const u32x4*)(vb_ + h0 + (size_t)(4096 + kt * 64 + r_st) * 64 + c8_st); }
    for (int it = 0; item >= 0; ++it) {
        const int nitem = attn_item(it + 1, G, wg);
        bf16x8 nqf[2]; u32x4 nk0, nv0, nk1, nv1;
        if (nitem >= 0) { const int qblk = 63 - (nitem >> 5), bhp = nitem & 31, bh0 = (bhp >> 2) * 8 + (bhp & 3) * 2; const size_t h0 = (size_t)bh0 * 4096 * 64, hm = h0 + (size_t)hsel * 4096 * 64;
            const int qrow = qblk * 64 + (wid & 3) * 16 + fr, kt = qblk;
            nqf[0] = *(const bf16x8*)(qb_ + hm + (size_t)qrow * 64 + fq * 8); nqf[1] = *(const bf16x8*)(qb_ + hm + (size_t)qrow * 64 + 32 + fq * 8);
            nk0 = *(const u32x4*)(kb_ + h0 + (size_t)(kt * 64 + r_st) * 64 + c8_st); nv0 = *(const u32x4*)(vb_ + h0 + (size_t)(kt * 64 + r_st) * 64 + c8_st);
            nk1 = *(const u32x4*)(kb_ + h0 + (size_t)(4096 + kt * 64 + r_st) * 64 + c8_st); nv1 = *(const u32x4*)(vb_ + h0 + (size_t)(4096 + kt * 64 + r_st) * 64 + c8_st); }
        const int qblk = 63 - (item >> 5), bhp = item & 31, bh0 = (bhp >> 2) * 8 + (bhp & 3) * 2, bh = bh0 + hsel;
        const bf16_t* kp = kb_ + (size_t)bh0 * 4096 * 64; const bf16_t* vp = vb_ + (size_t)bh0 * 4096 * 64;
        const int qmin = qblk * 64 + (wid & 3) * 16, qrow = qmin + fr;
        f32x4 o[4];
#pragma unroll
        for (int d = 0; d < 4; ++d) o[d] = (f32x4){0.f, 0.f, 0.f, 0.f};
        float carry = 0.f;
        if (tid < 16) flags[tid] = 0;
        int buf = 0;
        for (int kt = qblk; kt >= 0; --kt) {
            LAS bf16_t* Ks = (LAS bf16_t*)(lds + (buf * 2 + hsel) * 18432);
            LAS bf16_t* Vt = Ks + 64 * 72;
            {
                LAS bf16_t* K0 = (LAS bf16_t*)(lds + (buf * 2) * 18432); LAS bf16_t* V0 = K0 + 64 * 72; LAS bf16_t* K1 = K0 + 9216; LAS bf16_t* V1 = K1 + 64 * 72;
                *(LAS u32x4*)(K0 + r_st * 72 + c8_st) = kreg0; *(LAS u32x4*)(K1 + r_st * 72 + c8_st) = kreg1;
                V0[(c8_st + 0) * 72 + r_st] = (bf16_t)(vreg0.x & 0xffffu); V0[(c8_st + 1) * 72 + r_st] = (bf16_t)(vreg0.x >> 16);
                V0[(c8_st + 2) * 72 + r_st] = (bf16_t)(vreg0.y & 0xffffu); V0[(c8_st + 3) * 72 + r_st] = (bf16_t)(vreg0.y >> 16);
                V0[(c8_st + 4) * 72 + r_st] = (bf16_t)(vreg0.z & 0xffffu); V0[(c8_st + 5) * 72 + r_st] = (bf16_t)(vreg0.z >> 16);
                V0[(c8_st + 6) * 72 + r_st] = (bf16_t)(vreg0.w & 0xffffu); V0[(c8_st + 7) * 72 + r_st] = (bf16_t)(vreg0.w >> 16);
                V1[(c8_st + 0) * 72 + r_st] = (bf16_t)(vreg1.x & 0xffffu); V1[(c8_st + 1) * 72 + r_st] = (bf16_t)(vreg1.x >> 16);
                V1[(c8_st + 2) * 72 + r_st] = (bf16_t)(vreg1.y & 0xffffu); V1[(c8_st + 3) * 72 + r_st] = (bf16_t)(vreg1.y >> 16);
                V1[(c8_st + 4) * 72 + r_st] = (bf16_t)(vreg1.z & 0xffffu); V1[(c8_st + 5) * 72 + r_st] = (bf16_t)(vreg1.z >> 16);
                V1[(c8_st + 6) * 72 + r_st] = (bf16_t)(vreg1.w & 0xffffu); V1[(c8_st + 7) * 72 + r_st] = (bf16_t)(vreg1.w >> 16);
            }
            __syncthreads();
            { int alld = 1;
#pragma unroll
              for (int w = 0; w < 8; ++w) alld &= flags[(buf ^ 1) * 8 + w];
              if (alld) break; }
            if (kt > 0) {
                kreg0 = *(const u32x4*)(kp + (size_t)((kt - 1) * 64 + r_st) * 64 + c8_st); vreg0 = *(const u32x4*)(vp + (size_t)((kt - 1) * 64 + r_st) * 64 + c8_st);
                kreg1 = *(const u32x4*)(kp + (size_t)(4096 + (kt - 1) * 64 + r_st) * 64 + c8_st); vreg1 = *(const u32x4*)(vp + (size_t)(4096 + (kt - 1) * 64 + r_st) * 64 + c8_st);
            }
            const int key0 = kt * 64;
            int wdone = 0;
            if (key0 < qmin + 15) {
                f32x4 s[4];
#pragma unroll
                for (int n = 0; n < 4; ++n) { s[n] = (f32x4){0.f, 0.f, 0.f, 0.f};
#pragma unroll
                    for (int kk = 0; kk < 2; ++kk) { const bf16x8 kf = *(const LAS bf16x8*)(Ks + (n * 16 + fr) * 72 + kk * 32 + fq * 8); s[n] = __builtin_amdgcn_mfma_f32_16x16x32_bf16(kf, qf[kk], s[n], 0, 0, 0); } }
                const bool diag = (key0 + 63) >= qmin;
                f32x4 l1[4];
                if (diag) {
#pragma unroll
                    for (int n = 0; n < 4; ++n)
#pragma unroll
                        for (int j = 0; j < 4; ++j) { const float z = s[n][j]; const bool valid = (key0 + 16 * n + 4 * fq + j) < qrow;
                            const float sp = fmaxf(z, 0.f) + __builtin_amdgcn_logf(1.0f + __builtin_amdgcn_exp2f(-fabsf(z)));
                            l1[n][j] = valid ? -sp : 0.f; }
                } else {
#pragma unroll
                    for (int n = 0; n < 4; ++n)
#pragma unroll
                        for (int j = 0; j < 4; ++j) { const float z = s[n][j]; l1[n][j] = -(fmaxf(z, 0.f) + __builtin_amdgcn_logf(1.0f + __builtin_amdgcn_exp2f(-fabsf(z)))); }
                }
                f16x8 y0, y1;
#pragma unroll
                for (int j = 0; j < 4; ++j) { y0[j] = (_Float16)l1[0][j]; y0[4 + j] = (_Float16)l1[1][j]; y1[j] = (_Float16)l1[2][j]; y1[4 + j] = (_Float16)l1[3][j]; }
                f32x4 tl[4];
                const f32x4 z4 = (f32x4){0.f, 0.f, 0.f, 0.f};
                tl[0] = __builtin_amdgcn_mfma_f32_16x16x32_f16(mka, y0, z4, 0, 0, 0); tl[0] = __builtin_amdgcn_mfma_f32_16x16x32_f16(ones, y1, tl[0], 0, 0, 0);
                tl[1] = __builtin_amdgcn_mfma_f32_16x16x32_f16(mkb, y0, z4, 0, 0, 0); tl[1] = __builtin_amdgcn_mfma_f32_16x16x32_f16(ones, y1, tl[1], 0, 0, 0);
                tl[2] = __builtin_amdgcn_mfma_f32_16x16x32_f16(mka, y1, z4, 0, 0, 0);
                tl[3] = __builtin_amdgcn_mfma_f32_16x16x32_f16(mkb, y1, z4, 0, 0, 0);
                const float tot = __shfl(tl[0][0] + l1[0][0], fr);
                f32x4 w[4];
                if (diag) {
#pragma unroll
                    for (int n = 0; n < 4; ++n)
#pragma unroll
                        for (int j = 0; j < 4; ++j) { const bool valid = (key0 + 16 * n + 4 * fq + j) < qrow;
                            w[n][j] = valid ? __builtin_amdgcn_exp2f(s[n][j] + l1[n][j] + tl[n][j] + carry) : 0.f; }
                } else {
#pragma unroll
                    for (int n = 0; n < 4; ++n)
#pragma unroll
                        for (int j = 0; j < 4; ++j) w[n][j] = __builtin_amdgcn_exp2f(s[n][j] + l1[n][j] + tl[n][j] + carry);
                }
                carry += tot;
                bf16x8 wf[2];
#pragma unroll
                for (int P = 0; P < 2; ++P) { u32x4 t4; t4.x = pk2(w[2 * P][0], w[2 * P][1]); t4.y = pk2(w[2 * P][2], w[2 * P][3]); t4.z = pk2(w[2 * P + 1][0], w[2 * P + 1][1]); t4.w = pk2(w[2 * P + 1][2], w[2 * P + 1][3]); wf[P] = __builtin_bit_cast(bf16x8, t4); }
#pragma unroll
                for (int d = 0; d < 4; ++d)
#pragma unroll
                    for (int P = 0; P < 2; ++P) {
                        const LAS bf16_t* vr = Vt + (d * 16 + fr) * 72 + 32 * P + 4 * fq;
                        u32x4 t4; const u32x2 lo = *(const LAS u32x2*)vr, hi = *(const LAS u32x2*)(vr + 16); t4.x = lo.x; t4.y = lo.y; t4.z = hi.x; t4.w = hi.y;
                        o[d] = __builtin_amdgcn_mfma_f32_16x16x32_bf16(__builtin_bit_cast(bf16x8, t4), wf[P], o[d], 0, 0, 0);
                    }
                wdone = __all(carry < SB_EXIT) ? 1 : 0;
            }
            if (lane == 0) flags[buf * 8 + wid] = wdone;
            buf ^= 1;
        }
        { bf16_t* dst = mixed + (size_t)((bh >> 3) * 4096 + qrow) * 1024 + 512 + (bh & 7) * 64 + 4 * fq;
#pragma unroll
          for (int d = 0; d < 4; ++d) *(u32x2*)(dst + 16 * d) = pk4(o[d]); }
        __syncthreads();
        item = nitem;
        if (nitem >= 0) { qf[0] = nqf[0]; qf[1] = nqf[1]; kreg0 = nk0; vreg0 = nv0; kreg1 = nk1; vreg1 = nv1; }
    }
}

__device__ __forceinline__ void scan_unit(const Args& a, LAS unsigned char* lds, int pm) {
    const float* sloc = (const float*)(a.ws + WS_SLOC) + (size_t)pm * 256 * 128; bf16_t* ucat = (bf16_t*)(a.ws + WS_UCAT); const float* at = (const float*)(a.ws + WS_AT);
    const int tid = threadIdx.x;
    LAS f32x4* L4 = (LAS f32x4*)lds;
#pragma unroll 4
    for (int i = tid; i < 8192; i += 512) L4[i] = *(const f32x4*)(sloc + (size_t)i * 4);
    __syncthreads();
    if (tid < 128) {
        const int p = tid & 63, bs = tid >> 6, g = pm >> 2;
        const float ar = at[2 * (g * 64 + p)], ai = at[2 * (g * 64 + p) + 1];
        float xr = 0.f, xi = 0.f;
        const LAS float* Ls = (const LAS float*)lds + (bs * 128) * 128 + 2 * p;
        bf16_t* up = ucat + ((size_t)pm * 256 + bs * 128) * 640 + 512 + 2 * p;
#pragma unroll 4
        for (int sc = 0; sc < 128; ++sc) {
            *(unsigned*)(up + (size_t)sc * 640) = pk2(xr, xi);
            const float sr = Ls[sc * 128], si = Ls[sc * 128 + 1];
            const float nr = ar * xr - ai * xi + sr, ni = ar * xi + ai * xr + si; xr = nr; xi = ni;
        }
    }
    asm volatile("s_waitcnt vmcnt(0)" ::: "memory");
    __syncthreads();
}

__device__ __forceinline__ void pool_run(const Args& a, int g, int b, int run, int lane) {
    const bf16_t* h = (const bf16_t*)a.out; const float* ss3 = (const float*)(a.ws + WS_SS) + 3 * MTOK; bf16_t* yp = (bf16_t*)(a.ws + WS_YP);
    const int w = 2 << g, t0 = run * 32;
    const bf16_t* hp = h + (size_t)b * 4096 * 1024 + g * 256 + lane * 4; const float* sp = ss3 + b * 4096;
    f32x4 s = (f32x4){0.f, 0.f, 0.f, 0.f};
    for (int t = t0 - w + 1; t < t0; ++t) if (t >= 0) s += unpk4(*(const u32x2*)(hp + (size_t)t * 1024)) * rsqrtf(sp[t] * (1.0f / 1024.0f) + EPS);
#pragma unroll 4
    for (int t = t0; t < t0 + 32; ++t) {
        const f32x4 cur = unpk4(*(const u32x2*)(hp + (size_t)t * 1024)) * rsqrtf(sp[t] * (1.0f / 1024.0f) + EPS);
        s += cur;
        const float inv = 1.0f / (float)((t + 1) < w ? (t + 1) : w);
        *(u32x2*)(yp + ((size_t)g * MTOK + b * 4096 + t) * 256 + lane * 4) = pk4(s * inv - cur);
        const int told = t - w + 1;
        if (told >= 0) s -= unpk4(*(const u32x2*)(hp + (size_t)told * 1024)) * rsqrtf(sp[told] * (1.0f / 1024.0f) + EPS);
    }
}

#define XB_TMO      128
#define XB_XCNT(j)  (256  + 64 * (j))
#define XB_XSUB(j)  (1280 + 64 * (j))
#define XB_XGEN(j)  (2304 + 64 * (j))
#define XB_TOP      3328
#define XB_TOPGEN   3392
#define XCD_BAR_WORDS 3456
#define XB_SPIN_CAP (1u << 20)
__device__ __forceinline__ unsigned xb_ld(unsigned* p)              { return __hip_atomic_load(p, __ATOMIC_RELAXED, __HIP_MEMORY_SCOPE_AGENT); }
__device__ __forceinline__ unsigned xb_add(unsigned* p, unsigned v) { return __hip_atomic_fetch_add(p, v, __ATOMIC_RELAXED, __HIP_MEMORY_SCOPE_AGENT); }
__device__ __forceinline__ unsigned xb_xcc_id() { return (unsigned)__builtin_amdgcn_s_getreg((3 << 11) | 20) & 0xFu; }
#define XB_SPIN(cond, bar) do { unsigned _sp = 0; while (cond) { __builtin_amdgcn_s_sleep(1); \
    if ((++_sp & 255u) == 0u) { if (xb_ld(&(bar)[XB_TMO])) break; if (_sp > XB_SPIN_CAP) { atomicAdd(&(bar)[XB_TMO], 1u); break; } } } } while (0)
struct XcdBarrier { unsigned* bar; unsigned x; volatile LAS unsigned* st; };
__device__ __forceinline__ XcdBarrier xcd_barrier_post(unsigned* bar, volatile LAS unsigned* st) {
    XcdBarrier b; b.bar = bar; b.x = xb_xcc_id(); b.st = st;
    if (threadIdx.x == 0) (void)xb_add(&bar[XB_XCNT(b.x)], 1u);
    return b;
}
__device__ __forceinline__ void xcd_barrier_complete(unsigned* bar, unsigned x, unsigned& nloc, unsigned& nx) {
    const unsigned G = gridDim.x * gridDim.y * gridDim.z;
    unsigned sum, cnt, mine, sp = 0u;
    for (;;) {
        sum = 0u; cnt = 0u; mine = 0u;
#pragma unroll
        for (unsigned j = 0; j < 16; ++j) { const unsigned c = xb_ld(&bar[XB_XCNT(j)]); sum += c; cnt += (c > 0u) ? 1u : 0u; mine = (j == x) ? c : mine; }
        if (sum == G) break;
        __builtin_amdgcn_s_sleep(1);
        if ((++sp & 255u) == 0u) { if (xb_ld(&bar[XB_TMO])) break; if (sp > XB_SPIN_CAP) { atomicAdd(&bar[XB_TMO], 1u); break; } }
    }
    nloc = mine > 0u ? mine : 1u; nx = cnt > 0u ? cnt : 1u;
}
__device__ __forceinline__ void xcd_barrier(const XcdBarrier& b) {
    asm volatile("s_waitcnt vmcnt(0)" ::: "memory");
    __syncthreads();
    if (threadIdx.x == 0) {
        unsigned* bar = b.bar;
        __builtin_amdgcn_s_waitcnt(0);
        unsigned nloc = b.st[0], nx = b.st[1];
        if (nloc == 0u) { xcd_barrier_complete(bar, b.x, nloc, nx); b.st[0] = nloc; b.st[1] = nx; }
        const unsigned old = xb_add(&bar[XB_XSUB(b.x)], 1u);
        const unsigned gen = old / nloc;
        if (old + 1u == (gen + 1u) * nloc) {
            __builtin_amdgcn_fence(__ATOMIC_RELEASE, "agent");
            asm volatile("s_waitcnt vmcnt(0)" ::: "memory");
            const unsigned og = xb_add(&bar[XB_TOP], 1u);
            const unsigned tg = og / nx;
            if (og + 1u == (tg + 1u) * nx) xb_add(&bar[XB_TOPGEN], 1u);
            else XB_SPIN(xb_ld(&bar[XB_TOPGEN]) == tg, bar);
            __builtin_amdgcn_fence(__ATOMIC_ACQUIRE, "agent");
            xb_add(&bar[XB_XGEN(b.x)], 1u);
            asm volatile("s_waitcnt vmcnt(0)" ::: "memory");
        } else {
            XB_SPIN(xb_ld(&bar[XB_XGEN(b.x)]) == gen, bar);
            __builtin_amdgcn_fence(__ATOMIC_ACQUIRE, "agent");
            asm volatile("s_waitcnt vmcnt(0)" ::: "memory");
        }
    }
    __syncthreads();
}

__global__ void __launch_bounds__(512, 2) fwd_kernel(Args a) {
    extern __shared__ __attribute__((aligned(16))) unsigned char lds_raw[];
    LAS unsigned char* lds = (LAS unsigned char*)lds_raw;
    cg::grid_group grid = cg::this_grid();
    const int G = gridDim.x, wg = blockIdx.x;
    unsigned char* ws = a.ws;
    float* ssb = (float*)(ws + WS_SS);
    bf16_t* hb = (bf16_t*)(ws + WS_HB); bf16_t* eb = (bf16_t*)(ws + WS_EB);
    const int lo = a.ph_lo, hi = a.ph_hi;
#define IN(k) (PH_ON(k) && lo <= (k) && (k) < hi)
#define SEAM(k) do { if (lo <= (k) && (k) + 1 < hi) xcd_barrier(xbar); } while (0)
    if (threadIdx.x < 16) ((LAS unsigned*)(lds + 131072))[threadIdx.x] = 0u;
    __syncthreads();
    XcdBarrier xbar = xcd_barrier_post((unsigned*)(ws + WS_BAR), (volatile LAS unsigned*)(lds + 131072));
    if (hi > 1000) grid.sync();
    if (IN(0)) phase_prep(a, lds, wg, G);
    SEAM(0);
    if (IN(1)) {
        pg8::Gemm g{(const bf16_t*)a.out + (size_t)MTOK * 1024, (const bf16_t*)(ws + WS_WIN), 1024, 1024}; pg8::StaticOrder S; S.init(MTOK, 2048, G, wg);
        EpiIn E{ssb, (bf16_t*)(ws + WS_UCAT), (bf16_t*)(ws + WS_Q), (bf16_t*)(ws + WS_K), (bf16_t*)(ws + WS_V), a.in[I_QG], a.in[I_KG]};
        pg8::gemm_phase(lds, g, S, E);
    }
    SEAM(1);
    if (IN(2)) {
        unsigned* fl = (unsigned*)(ws + WS_BAR) + XCD_BAR_WORDS;
        {
            pg8::Gemm g{(const bf16_t*)(ws + WS_UCAT), (const bf16_t*)(ws + WS_WST), 640, 512}; pg8::OrderS S{G, wg};
            EpiS E{(float*)(ws + WS_SLOC)};
            pg8::gemm_phase(lds, g, S, E);
            for (int pm = wg; pm < 128; pm += G) {
                scan_unit(a, lds, pm);
                if (threadIdx.x == 0) { __builtin_amdgcn_fence(__ATOMIC_RELEASE, "agent"); asm volatile("s_waitcnt vmcnt(0)" ::: "memory"); __hip_atomic_store(fl + pm, 1u, __ATOMIC_RELAXED, __HIP_MEMORY_SCOPE_AGENT); }
            }
        }
        phase_attn(a, lds, wg, G);
        {
            if (threadIdx.x == 0) {
                for (int L = wg; L < 256; L += G) XB_SPIN(xb_ld(fl + (L >> 1)) < 1u, (unsigned*)(ws + WS_BAR));
                __builtin_amdgcn_fence(__ATOMIC_ACQUIRE, "agent"); asm volatile("s_waitcnt vmcnt(0)" ::: "memory");
            }
            __syncthreads();
            pg8::Gemm g{(const bf16_t*)(ws + WS_UCAT), (const bf16_t*)(ws + WS_WTZ), 640, 640}; pg8::OrderY S{G, wg};
            EpiY E{(const bf16_t*)(ws + WS_UCAT), a.in[I_D], (bf16_t*)(ws + WS_YBUF)};
            pg8::gemm_phase(lds, g, S, E);
            asm volatile("s_waitcnt vmcnt(0)" ::: "memory");
            __syncthreads();
            if (threadIdx.x == 0) { __builtin_amdgcn_fence(__ATOMIC_RELEASE, "agent"); asm volatile("s_waitcnt vmcnt(0)" ::: "memory");
                for (int L = wg; L < 256; L += G) xb_add(fl + 128 + 64 * ((L >> 1) & 3), 1u); }
        }
        {
            pg8::Gemm g{(const bf16_t*)(ws + WS_YBUF), (const bf16_t*)(ws + WS_WGLU), 512, 512}; pg8::StaticOrder S; S.init(MTOK, 512, G, wg);
            if (threadIdx.x == 0) {
                for (int j = 0; j < 4; ++j) XB_SPIN(xb_ld(fl + 128 + 64 * j) < 64u, (unsigned*)(ws + WS_BAR));
                __builtin_amdgcn_fence(__ATOMIC_ACQUIRE, "agent"); asm volatile("s_waitcnt vmcnt(0)" ::: "memory");
            }
            __syncthreads();
            EpiGlu E{(const bf16_t*)(ws + WS_YBUF), (bf16_t*)(ws + WS_MIXED)};
            pg8::gemm_phase(lds, g, S, E);
        }
    }
    SEAM(5);
    if (IN(6)) {
        pg8::Gemm g{(const bf16_t*)(ws + WS_MIXED), (const bf16_t*)(ws + WS_WOUT), 1024, 1024}; pg8::StaticOrder S; S.init(MTOK, 1024, G, wg);
        EpiRes<1> E{(const bf16_t*)a.out + (size_t)MTOK * 1024, hb, ssb + 1 * MTOK, nullptr};
        pg8::gemm_phase(lds, g, S, E);
    }
    SEAM(6);
#define MLP_UP(ph, li, ssi) if (IN(ph)) { \
        pg8::Gemm g{hb, (const bf16_t*)(ws + WS_WUP) + (size_t)(li) * 4096 * 1024, 1024, 1024}; pg8::StaticOrder S; S.init(MTOK, 4096, G, wg); \
        EpiUp E{ssb + (ssi) * MTOK, (bf16_t*)(ws + WS_HID)}; \
        pg8::gemm_phase(lds, g, S, E); }
#define MLP_DOWN(ph, li, ssi) if (IN(ph)) { \
        { pg8::Gemm g{(const bf16_t*)(ws + WS_HID), (const bf16_t*)(ws + WS_WDOWN) + (size_t)(li) * 1024 * 4096, 4096, 4096}; pg8::StaticOrder S; S.init(MTOK, 1024, G, wg, 1); \
          EpiRes<1> E{hb, hb, ssb + (ssi) * MTOK, nullptr}; \
          pg8::gemm_phase(lds, g, S, E); } \
        { int ke = 256; asm volatile("" : "+s"(ke)); pg8::Gemm g{(const bf16_t*)(ws + WS_PB) + (size_t)(li) * MTOK * 256, (const bf16_t*)(ws + WS_WPLE) + (size_t)(li) * 1024 * 256, ke, ke}; pg8::StaticOrder S; S.init(MTOK, 1024, G, wg); \
          EpiE E{eb}; \
          pg8::gemm_phase(lds, g, S, E); } }
#define PLE_GATE(ph, li, ssi, sso, FIN) if (IN(ph)) { \
        pg8::Gemm g{hb, (const bf16_t*)(ws + WS_WGATE) + (size_t)(li) * 1024 * 1024, 1024, 1024}; pg8::StaticOrder S; S.init(MTOK, 1024, G, wg); \
        EpiGate<FIN> E{hb, a.out, (bf16_t*)a.out, eb, ssb + (ssi) * MTOK, (sso)}; \
        pg8::gemm_phase(lds, g, S, E); }
    MLP_UP(7, 0, 1)
    SEAM(7);
    MLP_DOWN(8, 0, 2)
    SEAM(8);
    PLE_GATE(9, 0, 2, ssb + 3 * MTOK, false)
    SEAM(9);
    if (IN(11)) {
        for (int L = wg; L < 512; L += G) { const int pmr = L & 127; pool_run(a, L >> 7, pmr >> 4, (pmr & 15) * 8 + (int)(threadIdx.x >> 6), (int)(threadIdx.x & 63)); }
        asm volatile("s_waitcnt vmcnt(0)" ::: "memory"); __syncthreads();
        int kp = 256; asm volatile("" : "+s"(kp));
        pg8::Gemm g{(const bf16_t*)(ws + WS_YP), (const bf16_t*)(ws + WS_WPOOL), kp, kp}; pg8::OrderP S{G, wg};
        EpiRes<2> E{(const bf16_t*)a.out, hb, ssb + 4 * MTOK, a.in[I_POOLS]};
        pg8::gemm_phase(lds, g, S, E);
    }
    SEAM(11);
    MLP_UP(12, 1, 4)
    SEAM(12);
    MLP_DOWN(13, 1, 5)
    SEAM(13);
    PLE_GATE(14, 1, 5, (float*)nullptr, true)
}

extern "C" void kernel_launch(void* const* d_in, const int* in_sizes, int n_in, void* d_out, int out_size, void* d_ws, size_t ws_size, hipStream_t stream) {
    static int inited = 0;
    if (!inited) {
        if (n_in != 25 || ws_size < WS_END) { fprintf(stderr, "kernel_launch: unexpected n_in %d / ws_size %zu (need %zu)\n", n_in, ws_size, (size_t)WS_END); }
        hipFuncSetAttribute((const void*)fwd_kernel, hipFuncAttributeMaxDynamicSharedMemorySize, LDS_BYTES);
        inited = 1;
    }
    (void)hipMemsetAsync((unsigned char*)d_ws + WS_BAR, 0, (XCD_BAR_WORDS + 512) * 4, stream);
    Args a{};
    for (int i = 0; i < 25; ++i) a.in[i] = (const float*)d_in[i];
    a.out = (float*)d_out; a.ws = (unsigned char*)d_ws;
    a.ph_lo = 0; a.ph_hi = NPHASE;
    void* args[] = {&a};
    hipError_t e = hipLaunchCooperativeKernel((const void*)fwd_kernel, dim3(256), dim3(512), args, LDS_BYTES, stream);
    if (e != hipSuccess) fprintf(stderr, "cooperative launch failed: %s\n", hipGetErrorString(e));
}
```
